# Optimizing an MI355X kernel written in HIP

```python
import jax, jax.numpy as jnp
from jax import lax
import numpy as np

D_MODEL = 1024
BATCH = 8
SEQ = 2048
DEPTH = 1
DEC_BATCH = 16
DEC_SEQ = 64
PAST_LEN = 4096

CHUNK = 64
D_MIX = D_MODEL
D_A = D_MIX // 2
D_B = D_MIX - D_A
A_HEADS = 8
A_HEAD_DIM = D_A // A_HEADS
B_HEADS = 4
B_HEAD_DIM = D_B // B_HEADS
GMLP_CHUNK = 128
LRU_CONV = 4
LRU_C = 8.0
D_FF = 3 * D_MODEL
FFN_CONV = 3
D_IN = 2 * D_A + 2 * D_B
EPS = 1e-6

kernel_name = "hymba_rglru_gmlp_convffn_stream_step"


def rmsnorm(x, g):
    xf = x.astype(jnp.float32)
    y = xf * lax.rsqrt(jnp.mean(xf * xf, axis=-1, keepdims=True) + EPS) * g.astype(jnp.float32)
    return y.astype(x.dtype)


def layernorm(x, g, b):
    xf = x.astype(jnp.float32)
    mu = jnp.mean(xf, axis=-1, keepdims=True)
    var = jnp.mean(jnp.square(xf - mu), axis=-1, keepdims=True)
    y = (xf - mu) * lax.rsqrt(var + EPS) * g.astype(jnp.float32) + b.astype(jnp.float32)
    return y.astype(x.dtype)


def causal_dwconv(x, prev, w, b):
    k = w.shape[0]
    t = x.shape[1]
    xp = jnp.concatenate([prev.astype(x.dtype), x], axis=1)
    y = b
    for j in range(k):
        y = y + xp[:, j:j + t] * w[j]
    return y.astype(x.dtype), xp[:, xp.shape[1] - (k - 1):]


def rg_lru(x, h0, w_r, b_r, w_i, b_i, lam, reset_first):
    bsz, t, _ = x.shape
    xf = x.astype(jnp.float32)
    xh = xf.reshape(bsz, t, A_HEADS, A_HEAD_DIM)
    r = jax.nn.sigmoid(jnp.einsum('bthd,hde->bthe', xh, w_r.astype(jnp.float32)).reshape(bsz, t, D_A) + b_r)
    i = jax.nn.sigmoid(jnp.einsum('bthd,hde->bthe', xh, w_i.astype(jnp.float32)).reshape(bsz, t, D_A) + b_i)
    log_a = -LRU_C * r * jax.nn.softplus(-lam.astype(jnp.float32))
    a = jnp.exp(log_a)
    mult = jnp.sqrt(-jnp.expm1(2.0 * log_a))
    if reset_first:
        mult = mult.at[:, 0].set(1.0)
    bterm = mult * (i * xf)
    bterm = bterm.at[:, 0].add(a[:, 0] * h0.astype(jnp.float32))

    def combine(c1, c2):
        a1, b1 = c1
        a2, b2 = c2
        return a1 * a2, a2 * b1 + b2

    _, h = lax.associative_scan(combine, (a, bterm), axis=1)
    return h.astype(x.dtype), h[:, -1].astype(x.dtype)


def spatial_gate(u, vn, w_s, b_s):
    bsz, t, _ = vn.shape
    l = min(t, GMLP_CHUNK)
    n = t // l
    vh = vn.reshape(bsz, n, l, B_HEADS, B_HEAD_DIM)
    blk = jnp.arange(l) // CHUNK
    mask = blk[:, None] >= blk[None, :]
    w = jnp.where(mask[None], w_s[:, :l, :l], 0.0)
    s = jnp.einsum('hij,bcjhd->bcihd', w, vh) + b_s[:, :l].T[None, None, :, :, None]
    return (u * s.reshape(bsz, t, D_B)).astype(u.dtype)


def layer(x, h0, conv_prev, ffn_prev, reset_first,
          g_pre1, w_in, w_conv_a, b_conv_a, w_r, b_r, w_i, b_i, lam, g_out_a,
          g_v, b_v, w_s, b_s, g_out_b, w_o, g_post1,
          g_pre2, w_up, w_conv_f, b_conv_f, w_down, g_post2):
    hn = rmsnorm(x, g_pre1)
    z = hn @ w_in
    gate_a = z[..., :D_A]
    xa = z[..., D_A:2 * D_A]
    u = z[..., 2 * D_A:2 * D_A + D_B]
    v = z[..., 2 * D_A + D_B:]
    xa_c, new_conv = causal_dwconv(xa, conv_prev, w_conv_a, b_conv_a)
    h, h_last = rg_lru(xa_c, h0, w_r, b_r, w_i, b_i, lam, reset_first)
    ya = rmsnorm(h * jax.nn.gelu(gate_a), g_out_a)
    vn = layernorm(v, g_v, b_v)
    yb = rmsnorm(spatial_gate(u, vn, w_s, b_s), g_out_b)
    mix = jnp.concatenate([ya, yb], axis=-1) @ w_o
    x = x + rmsnorm(mix, g_post1)
    hn2 = rmsnorm(x, g_pre2)
    up = hn2 @ w_up
    upc, new_ffn = causal_dwconv(up, ffn_prev, w_conv_f, b_conv_f)
    f = (jax.nn.gelu(upc[..., :D_FF]) * upc[..., D_FF:]) @ w_down
    x = x + rmsnorm(f, g_post2)
    return x, h_last, new_conv, new_ffn, vn


def setup_inputs(seed: int = 0) -> dict:
    key = jax.random.key(seed)
    ks = iter(jax.random.split(key, 40))
    nrm = lambda shape, s: jax.random.normal(next(ks), shape, jnp.float32) * s
    gain = lambda shape: 1.0 + nrm(shape, 0.05)
    a_base = jax.random.uniform(next(ks), (DEPTH, D_A), jnp.float32, 0.9, 0.999)
    a_root = a_base ** (1.0 / LRU_C)
    lam = jnp.log(a_root) - jnp.log1p(-a_root)
    return {
        "x_prompt": nrm((BATCH, SEQ, D_MODEL), 1.0),
        "x_sample": nrm((DEC_BATCH, DEC_SEQ, D_MODEL), 1.0),
        "state_lru_h": nrm((DEPTH, DEC_BATCH, D_A), 0.5),
        "state_lru_conv": nrm((DEPTH, DEC_BATCH, LRU_CONV - 1, D_A), 1.0),
        "state_ffn_conv": nrm((DEPTH, DEC_BATCH, FFN_CONV - 1, 2 * D_FF), 1.0),
        "g_pre1": gain((DEPTH, D_MODEL)),
        "w_in": nrm((DEPTH, D_MODEL, D_IN), D_MODEL ** -0.5),
        "w_conv_a": nrm((DEPTH, LRU_CONV, D_A), LRU_CONV ** -0.5),
        "b_conv_a": nrm((DEPTH, D_A), 0.02),
        "w_r": nrm((DEPTH, A_HEADS, A_HEAD_DIM, A_HEAD_DIM), A_HEAD_DIM ** -0.5),
        "b_r": nrm((DEPTH, D_A), 0.02),
        "w_i": nrm((DEPTH, A_HEADS, A_HEAD_DIM, A_HEAD_DIM), A_HEAD_DIM ** -0.5),
        "b_i": nrm((DEPTH, D_A), 0.02),
        "lam": lam,
        "g_out_a": gain((DEPTH, D_A)),
        "g_v": gain((DEPTH, D_B)),
        "b_v": nrm((DEPTH, D_B), 0.02),
        "w_s": nrm((DEPTH, B_HEADS, GMLP_CHUNK, GMLP_CHUNK), GMLP_CHUNK ** -0.5),
        "b_s": gain((DEPTH, B_HEADS, GMLP_CHUNK)),
        "g_out_b": gain((DEPTH, D_B)),
        "w_o": nrm((DEPTH, D_MIX, D_MODEL), D_MIX ** -0.5),
        "g_post1": gain((DEPTH, D_MODEL)),
        "g_pre2": gain((DEPTH, D_MODEL)),
        "w_up": nrm((DEPTH, D_MODEL, 2 * D_FF), D_MODEL ** -0.5),
        "w_conv_f": nrm((DEPTH, FFN_CONV, 2 * D_FF), FFN_CONV ** -0.5),
        "b_conv_f": nrm((DEPTH, 2 * D_FF), 0.02),
        "w_down": nrm((DEPTH, D_FF, D_MODEL), D_FF ** -0.5),
        "g_post2": gain((DEPTH, D_MODEL)),
    }


def reference(x_prompt, x_sample, state_lru_h, state_lru_conv, state_ffn_conv,
              g_pre1, w_in, w_conv_a, b_conv_a, w_r, b_r, w_i, b_i, lam, g_out_a,
              g_v, b_v, w_s, b_s, g_out_b, w_o, g_post1,
              g_pre2, w_up, w_conv_f, b_conv_f, w_down, g_post2):
    bp = x_prompt.shape[0]
    xp, xs = x_prompt, x_sample
    hp_l, cp_l, fp_l, hs_l, cs_l, fs_l, vs_l = [], [], [], [], [], [], []
    for l in range(DEPTH):
        w = (g_pre1[l], w_in[l], w_conv_a[l], b_conv_a[l], w_r[l], b_r[l], w_i[l], b_i[l], lam[l],
             g_out_a[l], g_v[l], b_v[l], w_s[l], b_s[l], g_out_b[l], w_o[l], g_post1[l],
             g_pre2[l], w_up[l], w_conv_f[l], b_conv_f[l], w_down[l], g_post2[l])
        h0_p = jnp.zeros((bp, D_A), xp.dtype)
        conv0_p = jnp.zeros((bp, LRU_CONV - 1, D_A), xp.dtype)
        ffn0_p = jnp.zeros((bp, FFN_CONV - 1, 2 * D_FF), xp.dtype)
        xp, hp, cp, fp, _ = layer(xp, h0_p, conv0_p, ffn0_p, True, *w)
        xs, hs, cs, fs, vs = layer(xs, state_lru_h[l], state_lru_conv[l], state_ffn_conv[l], False, *w)
        hp_l.append(hp); cp_l.append(cp); fp_l.append(fp)
        hs_l.append(hs); cs_l.append(cs); fs_l.append(fs); vs_l.append(vs)
    return (xp, xs,
            jnp.stack(hp_l), jnp.stack(cp_l), jnp.stack(fp_l),
            jnp.stack(hs_l), jnp.stack(cs_l), jnp.stack(fs_l), jnp.stack(vs_l))
```

```cpp
#include <hip/hip_runtime.h>
#include <hip/hip_cooperative_groups.h>
#include <cstdio>
#include <cstdint>
namespace cg = cooperative_groups;
namespace pg8 {
#define PG8_LAS __attribute__((address_space(3)))
typedef unsigned short bf16_t;
typedef short bf16x8 __attribute__((ext_vector_type(8)));
typedef float f32x4 __attribute__((ext_vector_type(4)));
typedef unsigned u32x4 __attribute__((ext_vector_type(4)));
constexpr int BM = 256, BK = 64, HALF = 128, HTB = HALF * BK * 2  , STAGE_BYTES = 8 * HTB, NXCD = 8, WGM = 8;

__host__ __device__ __forceinline__ int lds_byte(int r, int c) { const int st = (r >> 4) * 2 + (c >> 5), rr = r & 15, cc = c & 31, ob = rr * 64 + cc * 2; return st * 1024 + (ob ^ (((ob >> 9) & 1) << 5)); }
__host__ __device__ __forceinline__ void stage_rc(int b, int& R, int& C) { const int st = b / 1024, sb = b % 1024, swz = sb ^ (((sb >> 9) & 1) << 5); R = (st >> 1) * 16 + swz / 64; C = (st & 1) * 32 + (swz % 64) / 2; }
__host__ __device__ __forceinline__ int perm32(int rho) { const int n = rho >> 4, i = rho & 15; return 8 * (i >> 2) + 4 * n + (i & 3); }

struct Unit { int pm, pn; };
struct Gemm { const bf16_t* A; const bf16_t* Bt; int M, N, K; };

struct StaticOrder {
    int nM, nN, nwg, G, c;
    __host__ __device__ void init(int M, int N, int G_, int c_) { nM = M / BM; nN = N / BM; nwg = nM * nN; G = G_; c = c_; }
    __host__ __device__ bool next(int i, Unit& u) const {
        const long L = (long)i * G + c; if (L >= nwg) return false;
        int wgid = (int)L; { const int q = nwg / NXCD, r = nwg % NXCD, xcd = wgid % NXCD, off = wgid / NXCD; wgid = (xcd < r ? xcd * (q + 1) : r * (q + 1) + (xcd - r) * q) + off; }
        const int nig = WGM * nN, gid = wgid / nig, fm = gid * WGM, gsz = (nM - fm) < WGM ? (nM - fm) : WGM;
        u.pm = fm + ((wgid % nig) % gsz); u.pn = (wgid % nig) / gsz; return true;
    }
    __device__ __forceinline__ void a_ready(const Unit&) const {}
    __device__ __forceinline__ void done(const Unit&) const {}
};

__device__ __forceinline__ unsigned cvt_pk_bf16(float lo, float hi) { unsigned r; asm volatile("v_cvt_pk_bf16_f32 %0, %1, %2" : "=v"(r) : "v"(lo), "v"(hi)); return r; }
typedef float f32x2 __attribute__((ext_vector_type(2)));
__device__ __forceinline__ f32x2 gelu_pk(f32x2 v) {
    const f32x2 av = __builtin_elementwise_abs(v), d = av * 0.2316418882f + 1.0f;
    f32x2 t; t.x = __builtin_amdgcn_rcpf(d.x); t.y = __builtin_amdgcn_rcpf(d.y);
    f32x2 q = t * 0.5307027145f + (-0.7265760135f); q = q * t + 0.7107068705f; q = q * t + (-0.142248368f); q = q * t + 0.127414796f; q = q * t;
    const f32x2 s = (v * v) * (-0.72134752044f);
    f32x2 e; e.x = __builtin_amdgcn_exp2f(s.x); e.y = __builtin_amdgcn_exp2f(s.y);
    const f32x2 m = v * (q * e), r = v - m;
    f32x2 o; o.x = v.x < 0.f ? m.x : r.x; o.y = v.y < 0.f ? m.y : r.y; return o;
}

template <int ACT  > struct EpiBf16 {
    static constexpr bool PERM = true, AFTER_DRAIN = false; static_assert(ACT == 0 || ACT == 1, "EpiBf16: ACT is 0 (none) or 1 (gelu_pk)");
    bf16_t* O; int ldc; const float* bias; int split_cols; size_t split_stride; float scale0;
    __device__ __forceinline__ void operator()(const f32x4 (&acc)[2][2][4][2], const Unit& u, int wr, int wc, int fr, int fq) const {
        const int row0 = u.pm * BM + wr * 64 + fr; int colt = u.pn * BM; bf16_t* base = O;
        float sc = 1.f; if (split_cols) { const int t = colt / split_cols; base += (size_t)t * split_stride; colt -= t * split_cols; if (t == 0) sc = scale0; }
        const int col0 = colt + wc * 32 + 8 * fq, bcol0 = u.pn * BM + wc * 32 + 8 * fq;
        f32x4 bv[2][2];
#pragma unroll
        for (int bj = 0; bj < 2; ++bj)
#pragma unroll
            for (int n = 0; n < 2; ++n) bv[bj][n] = bias ? *(const f32x4*)(bias + bcol0 + bj * HALF + 4 * n) : (f32x4){0.f, 0.f, 0.f, 0.f};
#pragma unroll
        for (int ai = 0; ai < 2; ++ai)
#pragma unroll
            for (int m = 0; m < 4; ++m) { bf16_t* rowp = base + (size_t)(row0 + ai * HALF + m * 16) * ldc + col0;
#pragma unroll
                for (int bj = 0; bj < 2; ++bj) { f32x4 v0 = acc[ai][bj][m][0] + bv[bj][0], v1 = acc[ai][bj][m][1] + bv[bj][1];
                    if (ACT == 1) { f32x2 a = gelu_pk((f32x2){v0[0], v0[1]}), b = gelu_pk((f32x2){v0[2], v0[3]}), c = gelu_pk((f32x2){v1[0], v1[1]}), d = gelu_pk((f32x2){v1[2], v1[3]});
                        v0 = (f32x4){a.x, a.y, b.x, b.y}; v1 = (f32x4){c.x, c.y, d.x, d.y}; }
                    v0 = v0 * sc; v1 = v1 * sc; u32x4 w; w.x = cvt_pk_bf16(v0[0], v0[1]); w.y = cvt_pk_bf16(v0[2], v0[3]); w.z = cvt_pk_bf16(v1[0], v1[1]); w.w = cvt_pk_bf16(v1[2], v1[3]);
                    *(u32x4*)(rowp + bj * HALF) = w; } }
    }
};
struct EpiF32 {
    static constexpr bool PERM = false, AFTER_DRAIN = false;
    float* C; int ldc; const float* bias;
    __device__ __forceinline__ void operator()(const f32x4 (&acc)[2][2][4][2], const Unit& u, int wr, int wc, int fr, int fq) const {
        const int row0 = u.pm * BM + wr * 64 + fr, col0 = u.pn * BM + wc * 32 + 4 * fq;
        f32x4 bv[2][2];
#pragma unroll
        for (int bj = 0; bj < 2; ++bj)
#pragma unroll
            for (int n = 0; n < 2; ++n) bv[bj][n] = bias ? *(const f32x4*)(bias + col0 + bj * HALF + n * 16) : (f32x4){0.f, 0.f, 0.f, 0.f};
#pragma unroll
        for (int ai = 0; ai < 2; ++ai)
#pragma unroll
            for (int m = 0; m < 4; ++m) { float* rowp = C + (size_t)(row0 + ai * HALF + m * 16) * ldc + col0;
#pragma unroll
                for (int bj = 0; bj < 2; ++bj)
#pragma unroll
                    for (int n = 0; n < 2; ++n) *(f32x4*)(rowp + bj * HALF + n * 16) = acc[ai][bj][m][n] + bv[bj][n]; }
    }
};
__device__ __forceinline__ float dpp_shr1(float old, float src) { return __builtin_bit_cast(float, __builtin_amdgcn_update_dpp(__builtin_bit_cast(int, old), __builtin_bit_cast(int, src), 0x111, 0xf, 0xf, false)); }
__device__ __forceinline__ float dpp_shr2(float old, float src) { return __builtin_bit_cast(float, __builtin_amdgcn_update_dpp(__builtin_bit_cast(int, old), __builtin_bit_cast(int, src), 0x112, 0xf, 0xf, false)); }
__device__ __forceinline__ float dpp_ror1(float src) { return __builtin_bit_cast(float, __builtin_amdgcn_update_dpp(0, __builtin_bit_cast(int, src), 0x121, 0xf, 0xf, false)); }
__device__ __forceinline__ float dpp_ror2(float src) { return __builtin_bit_cast(float, __builtin_amdgcn_update_dpp(0, __builtin_bit_cast(int, src), 0x122, 0xf, 0xf, false)); }
__device__ __forceinline__ float gelu_tanh(float x) {
    const float t = x * x, inner = x * (2.302208198f + 0.102943240f * t);
    return x * __builtin_amdgcn_rcpf(1.0f + __builtin_amdgcn_exp2f(-inner));
}
__device__ __forceinline__ f32x4 bf4_to_f4(const bf16_t* p) { const unsigned long long w = *(const unsigned long long*)p;
    return (f32x4){__builtin_bit_cast(float, (unsigned)(w << 16)), __builtin_bit_cast(float, (unsigned)w & 0xffff0000u), __builtin_bit_cast(float, (unsigned)(w >> 32) << 16), __builtin_bit_cast(float, (unsigned)(w >> 32) & 0xffff0000u)}; }

struct EpiConvGeglu {
    static constexpr bool PERM = true, AFTER_DRAIN = false;
    bf16_t* HB;
    const bf16_t* UB;
    const float* state;
    const float* wcv;
    const float* bcv;
    float* out_p;
    float* out_s;
    __device__ __forceinline__ void operator()(const f32x4 (&acc)[2][2][4][2], const Unit& u, int wr, int wc, int fr, int fq) const {
        const int cgb = u.pn * 128 + wc * 32 + 8 * fq;
        const int npb = u.pn * 256 + wc * 32 + 8 * fq;
#pragma unroll
        for (int n = 0; n < 2; ++n) {
            const int cg = cgb + 4 * n;
            const f32x4 w0g = *(const f32x4*)(wcv + cg), w1g = *(const f32x4*)(wcv + 6144 + cg), w2g = *(const f32x4*)(wcv + 12288 + cg), bg = *(const f32x4*)(bcv + cg);
            const f32x4 w0v = *(const f32x4*)(wcv + 3072 + cg), w1v = *(const f32x4*)(wcv + 6144 + 3072 + cg), w2v = *(const f32x4*)(wcv + 12288 + 3072 + cg), bv = *(const f32x4*)(bcv + 3072 + cg);
#pragma unroll
            for (int ai = 0; ai < 2; ++ai) {
                const int r0 = u.pm * BM + ai * HALF + wr * 64;
                f32x4 c1g, c2g, c1v, c2v;
                if (r0 >= 16384) { const float* st = state + (size_t)((r0 - 16384) >> 6) * 2 * 6144;
                    c2g = *(const f32x4*)(st + cg); c1g = *(const f32x4*)(st + 6144 + cg); c2v = *(const f32x4*)(st + 3072 + cg); c1v = *(const f32x4*)(st + 6144 + 3072 + cg); }
                else if ((r0 & 2047) == 0) { c1g = c2g = c1v = c2v = (f32x4){0.f, 0.f, 0.f, 0.f}; }
                else { const bf16_t* ub = UB + (size_t)(2 * (r0 >> 6)) * 6144 + npb + 4 * n;
                    c2g = bf4_to_f4(ub); c1g = bf4_to_f4(ub + 6144); c2v = bf4_to_f4(ub + 128); c1v = bf4_to_f4(ub + 6144 + 128); }
#pragma unroll
                for (int m = 0; m < 4; ++m) {
                    const f32x4 xg = acc[ai][0][m][n], xv = acc[ai][1][m][n];
                    f32x4 o1g, o2g, o1v, o2v;
                    if (m == 0) { o1g = c1g; o1v = c1v; o2g = (fr == 0) ? c2g : c1g; o2v = (fr == 0) ? c2v : c1v; }
                    else { const f32x4 pg = acc[ai][0][m > 0 ? m - 1 : 0][n], pv = acc[ai][1][m > 0 ? m - 1 : 0][n];
#pragma unroll
                        for (int e = 0; e < 4; ++e) { o1g[e] = dpp_ror1(pg[e]); o2g[e] = dpp_ror2(pg[e]); o1v[e] = dpp_ror1(pv[e]); o2v[e] = dpp_ror2(pv[e]); } }
                    float res[4];
#pragma unroll
                    for (int e = 0; e < 4; ++e) {
                        const float g1 = dpp_shr1(o1g[e], xg[e]), g2 = dpp_shr2(o2g[e], xg[e]);
                        const float v1 = dpp_shr1(o1v[e], xv[e]), v2 = dpp_shr2(o2v[e], xv[e]);
                        const float cgv = bg[e] + w0g[e] * g2 + w1g[e] * g1 + w2g[e] * xg[e];
                        const float cvv = bv[e] + w0v[e] * v2 + w1v[e] * v1 + w2v[e] * xv[e];
                        res[e] = gelu_tanh(cgv) * cvv;
                    }
                    typedef unsigned u32x2v __attribute__((ext_vector_type(2)));
                    u32x2v w; w.x = cvt_pk_bf16(res[0], res[1]); w.y = cvt_pk_bf16(res[2], res[3]);
                    *(u32x2v*)(HB + (size_t)(r0 + 16 * m + fr) * 3072 + cg) = w;
                }
                const bool smp = r0 >= 16384;
                if ((smp || (((r0 + 64) & 2047) == 0)) && fr >= 14) {
                    float* o = (smp ? out_s + (size_t)((r0 - 16384) >> 6) * 2 * 6144 : out_p + (size_t)(r0 >> 11) * 2 * 6144) + (fr - 14) * 6144;
                    *(f32x4*)(o + cg) = acc[ai][0][3][n]; *(f32x4*)(o + 3072 + cg) = acc[ai][1][3][n];
                }
            }
        }
    }
};
template <class Epi, class Sched, bool ALIGN_EPI = false, bool SP2 = false>
__device__ __forceinline__ void gemm_phase(PG8_LAS unsigned char* lds, const Gemm g, const Sched& S, const Epi& E) {
    const int tid = threadIdx.x, wid = __builtin_amdgcn_readfirstlane(tid >> 6), lane = tid & 63, wr = wid >> 2, wc = wid & 3, fr = lane & 15, fq = lane >> 4;
    const int K = g.K, nt = K / BK;
    unsigned voffA[2], voffB[2];
#pragma unroll
    for (int i = 0; i < 2; ++i) { int R, C; stage_rc(tid * 16 + i * 8192, R, C); const int Rb = Epi::PERM ? ((R & ~31) + perm32(R & 31)) : R;
        voffA[i] = (unsigned)(R * K + C) * 2u; voffB[i] = (unsigned)(Rb * K + C) * 2u; }
    const size_t kstep = (size_t)(BK * 2);
    const size_t hstep = (size_t)HALF * K * 2;
    const size_t tstep = 2 * hstep;
    const unsigned ldsw = (unsigned)wid * 1024u;
    const int aoff = lds_byte(wr * 64 + fr, fq * 8), boff = lds_byte(wc * 32 + fr, fq * 8);
#define PG8_SA(b, h) (((b) * 2 + (h)) * HTB)
#define PG8_SB(b, h) ((4 + (b) * 2 + (h)) * HTB)
#define PG8_STAGE(bufoff, gbase, voff) do { _Pragma("unroll") for (int _i = 0; _i < 2; ++_i) \
        __builtin_amdgcn_global_load_lds((const unsigned*)((const char*)(gbase) + (voff)[_i]), (PG8_LAS unsigned*)(lds + (bufoff) + ldsw + _i * 8192), 16, 0, 0); } while (0)
#define PG8_LDA(dst, b, h) do { _Pragma("unroll") for (int m = 0; m < 4; ++m) _Pragma("unroll") for (int k = 0; k < 2; ++k) dst[m][k] = *(const PG8_LAS bf16x8*)(lds + PG8_SA(b, h) + aoff + m * 2048 + k * 1024); } while (0)
#define PG8_LDB(dst, b, h) do { _Pragma("unroll") for (int n = 0; n < 2; ++n) _Pragma("unroll") for (int k = 0; k < 2; ++k) dst[n][k] = *(const PG8_LAS bf16x8*)(lds + PG8_SB(b, h) + boff + n * 2048 + k * 1024); } while (0)
#define PG8_MMA(ai, bj, At, Bt) do { __builtin_amdgcn_s_setprio(1); _Pragma("unroll") for (int m = 0; m < 4; ++m) _Pragma("unroll") for (int n = 0; n < 2; ++n) _Pragma("unroll") for (int k = 0; k < 2; ++k) \
        acc[ai][bj][m][n] = __builtin_amdgcn_mfma_f32_16x16x32_bf16(Bt[n][k], At[m][k], acc[ai][bj][m][n], 0, 0, 0); __builtin_amdgcn_s_setprio(0); } while (0)
#define PG8_WAIT_V(n) asm volatile("s_waitcnt vmcnt(" #n ")" ::: "memory")
#define PG8_WAIT_L(n) asm volatile("s_waitcnt lgkmcnt(" #n ")" ::: "memory")
#define PG8_BAR __builtin_amdgcn_s_barrier()
#define PG8_SCHED __builtin_amdgcn_sched_barrier(0)
    Unit cur, nxt; int ui = 0;
    if (!S.next(0, cur)) return;
    f32x4 acc[2][2][4][2];
#pragma unroll
    for (int a = 0; a < 2; ++a)
#pragma unroll
        for (int b = 0; b < 2; ++b)
#pragma unroll
            for (int m = 0; m < 4; ++m)
#pragma unroll
                for (int n = 0; n < 2; ++n) acc[a][b][m][n] = (f32x4){0.f, 0.f, 0.f, 0.f};
    bf16x8 At[4][2], B0[2][2], B1[2][2];
    const char* cA = (const char*)g.A + (size_t)cur.pm * tstep; const char* cB = (const char*)g.Bt + (size_t)cur.pn * tstep;
    S.a_ready(cur);
    if constexpr (SP2) {
        PG8_STAGE(PG8_SB(0, 0), cB, voffB); PG8_STAGE(PG8_SB(0, 1), cB + hstep, voffB); PG8_STAGE(PG8_SA(0, 0), cA, voffA); PG8_STAGE(PG8_SA(0, 1), cA + hstep, voffA);
        if (wr == 1) PG8_BAR;
        PG8_WAIT_V(2); PG8_BAR;
        PG8_STAGE(PG8_SB(1, 0), cB + kstep, voffB); PG8_STAGE(PG8_SA(1, 0), cA + kstep, voffA); PG8_STAGE(PG8_SB(1, 1), cB + hstep + kstep, voffB);
        PG8_WAIT_V(6); PG8_BAR;
    } else {
        PG8_STAGE(PG8_SB(0, 0), cB, voffB); PG8_STAGE(PG8_SA(0, 0), cA, voffA); PG8_STAGE(PG8_SB(0, 1), cB + hstep, voffB); PG8_STAGE(PG8_SA(0, 1), cA + hstep, voffA);
        if (wr == 1) PG8_BAR;
        PG8_WAIT_V(4); PG8_BAR;
        PG8_STAGE(PG8_SB(1, 0), cB + kstep, voffB); PG8_STAGE(PG8_SA(1, 0), cA + kstep, voffA); PG8_STAGE(PG8_SB(1, 1), cB + hstep + kstep, voffB);
        PG8_WAIT_V(6); PG8_BAR;
    }
    for (;;) {
        const bool has_next = S.next(ui + 1, nxt);
        const char* nA = has_next ? (const char*)g.A + (size_t)nxt.pm * tstep : cA; const char* nB = has_next ? (const char*)g.Bt + (size_t)nxt.pn * tstep : cB;
        for (int t = 0; t < nt; t += 2) {
            const bool last = (t == nt - 2);
            const char* a1 = cA + (size_t)(t + 1) * kstep;
            const char* a2 = last ? nA : cA + (size_t)(t + 2) * kstep; const char* b2 = last ? nB : cB + (size_t)(t + 2) * kstep;
            const char* a3 = a2 + kstep; const char* b3 = b2 + kstep;
            if (last && has_next) S.a_ready(nxt);
            if constexpr (SP2) {
            PG8_LDB(B0, 0, 0); PG8_LDB(B1, 0, 1); PG8_SCHED; PG8_LDA(At, 0, 0); PG8_STAGE(PG8_SA(1, 1), a1 + hstep, voffA);
            PG8_WAIT_V(8); PG8_WAIT_L(0); PG8_BAR; PG8_MMA(0, 0, At, B0); PG8_MMA(0, 1, At, B1); PG8_BAR; PG8_SCHED;
            PG8_LDA(At, 0, 1); PG8_STAGE(PG8_SB(0, 0), b2, voffB); PG8_STAGE(PG8_SB(0, 1), b2 + hstep, voffB); PG8_STAGE(PG8_SA(0, 0), a2, voffA);
            PG8_WAIT_V(8); PG8_WAIT_L(0); PG8_BAR; PG8_MMA(1, 0, At, B0); PG8_MMA(1, 1, At, B1); PG8_BAR; PG8_SCHED;
            PG8_LDB(B0, 1, 0); PG8_LDB(B1, 1, 1); PG8_SCHED; PG8_LDA(At, 1, 0); PG8_STAGE(PG8_SA(0, 1), a2 + hstep, voffA);
            PG8_WAIT_V(8); PG8_WAIT_L(0); PG8_BAR; PG8_MMA(0, 0, At, B0); PG8_MMA(0, 1, At, B1); PG8_BAR; PG8_SCHED;
            PG8_LDA(At, 1, 1); PG8_STAGE(PG8_SB(1, 0), b3, voffB); PG8_STAGE(PG8_SB(1, 1), b3 + hstep, voffB); PG8_STAGE(PG8_SA(1, 0), a3, voffA);
            PG8_WAIT_V(8); PG8_WAIT_L(0); PG8_BAR; PG8_MMA(1, 0, At, B0); PG8_MMA(1, 1, At, B1); PG8_BAR; PG8_SCHED;
            } else {
            PG8_LDB(B0, 0, 0); PG8_SCHED; PG8_LDA(At, 0, 0); PG8_STAGE(PG8_SA(1, 1), a1 + hstep, voffA);
            PG8_WAIT_L(8); PG8_BAR; PG8_WAIT_L(0); PG8_MMA(0, 0, At, B0); PG8_BAR; PG8_SCHED;
            PG8_LDB(B1, 0, 1); PG8_STAGE(PG8_SB(0, 0), b2, voffB);
            PG8_BAR; PG8_WAIT_L(0); PG8_MMA(0, 1, At, B1); PG8_BAR;
            PG8_LDA(At, 0, 1); PG8_STAGE(PG8_SA(0, 0), a2, voffA);
            PG8_BAR; PG8_WAIT_L(0); PG8_MMA(1, 0, At, B0); PG8_BAR; PG8_SCHED;
            PG8_STAGE(PG8_SB(0, 1), b2 + hstep, voffB);
            PG8_WAIT_V(6); PG8_BAR; PG8_MMA(1, 1, At, B1); PG8_BAR;
            PG8_LDB(B0, 1, 0); PG8_SCHED; PG8_LDA(At, 1, 0); PG8_STAGE(PG8_SA(0, 1), a2 + hstep, voffA);
            PG8_WAIT_L(8); PG8_BAR; PG8_WAIT_L(0); PG8_MMA(0, 0, At, B0); PG8_BAR; PG8_SCHED;
            PG8_LDB(B1, 1, 1); PG8_STAGE(PG8_SB(1, 0), b3, voffB);
            PG8_BAR; PG8_WAIT_L(0); PG8_MMA(0, 1, At, B1); PG8_BAR;
            PG8_LDA(At, 1, 1); PG8_STAGE(PG8_SA(1, 0), a3, voffA);
            PG8_BAR; PG8_WAIT_L(0); PG8_MMA(1, 0, At, B0); PG8_BAR; PG8_SCHED;
            PG8_STAGE(PG8_SB(1, 1), b3 + hstep, voffB);
            PG8_WAIT_V(6); PG8_BAR; PG8_MMA(1, 1, At, B1); PG8_BAR;
            }
        }
        if constexpr (ALIGN_EPI) { if (wr == 0) PG8_BAR; }
        if constexpr (!Epi::AFTER_DRAIN) { E(acc, cur, wr, wc, fr, fq); S.done(cur); }
        if (!has_next) break;
#pragma unroll
        for (int a = 0; a < 2; ++a)
#pragma unroll
            for (int b = 0; b < 2; ++b)
#pragma unroll
                for (int m = 0; m < 4; ++m)
#pragma unroll
                    for (int n = 0; n < 2; ++n) acc[a][b][m][n] = (f32x4){0.f, 0.f, 0.f, 0.f};
        cur = nxt; cA = nA; cB = nB; ++ui;
        if constexpr (ALIGN_EPI) { if (wr == 1) PG8_BAR; }
    }
    PG8_WAIT_V(0);
    if constexpr (!ALIGN_EPI) { if (wr == 0) PG8_BAR; }
    PG8_BAR;
    if constexpr (Epi::AFTER_DRAIN) { E.fused(acc, cur, wr, wc, fr, fq, lds, wid, lane); S.done(cur); }
#undef PG8_SA
#undef PG8_SB
#undef PG8_STAGE
#undef PG8_LDA
#undef PG8_LDB
#undef PG8_MMA
#undef PG8_WAIT_V
#undef PG8_WAIT_L
#undef PG8_BAR
#undef PG8_SCHED
}
}

constexpr int D = 1024, NB = 8, SEQ = 2048, NS = 16, SSEQ = 64, MP = NB * SEQ, M = MP + NS * SSEQ;
constexpr int DA = 512, DB = 512, DIN = 2048, FF = 3072, FF2 = 6144;
constexpr float EPS = 1e-6f;
constexpr size_t O_Y = 0, O_HP = (size_t)M * D, O_CP = O_HP + NB * DA, O_FP = O_CP + NB * 3 * DA, O_HS = O_FP + NB * 2 * FF2, O_CS = O_HS + NS * DA, O_FS = O_CS + NS * 3 * DA, O_VS = O_FS + NS * 2 * FF2,
                 O_END = O_VS + (size_t)NS * SSEQ * DB;
constexpr size_t MiB = 1u << 20;
constexpr size_t WS_WIN = 2 * MiB, WS_WO = 6 * MiB, WS_WUP = 8 * MiB, WS_WDN = 20 * MiB, WS_XN = 26 * MiB, WS_Z = 60 * MiB, WS_MIX = 128 * MiB, WS_HB = 60 * MiB, WS_F = 162 * MiB,
                 WS_XNB = 230 * MiB, WS_UB = 231 * MiB, WS_AGG = 237 * MiB, WS_WRF = 238 * MiB, WS_END = 239 * MiB;
constexpr int LDS_BYTES = 147456;

#define GAS __attribute__((address_space(1)))
#define LAS __attribute__((address_space(3)))
typedef unsigned short bf16;
typedef float f32x4 __attribute__((ext_vector_type(4)));
typedef short bf16x8 __attribute__((ext_vector_type(8)));
typedef unsigned v4u __attribute__((ext_vector_type(4)));
typedef unsigned v2u __attribute__((ext_vector_type(2)));
#define LDS_WAIT() asm volatile("s_waitcnt lgkmcnt(0)" ::: "memory")

__device__ __forceinline__ unsigned f2bf(float f) { unsigned u = __builtin_bit_cast(unsigned, f); return (u + 0x7fffu + ((u >> 16) & 1u)) >> 16; }
__device__ __forceinline__ unsigned pk2(float lo, float hi) { return f2bf(lo) | (f2bf(hi) << 16); }
__device__ __forceinline__ float bf2f(bf16 b) { return __builtin_bit_cast(float, (unsigned)b << 16); }
__device__ __forceinline__ float wave_sum(float v) {
#pragma unroll
    for (int o = 1; o < 64; o <<= 1) v += __shfl_xor(v, o);
    return v;
}
__device__ __forceinline__ float sigmoidf_(float z) { return __builtin_amdgcn_rcpf(1.0f + __builtin_amdgcn_exp2f(-1.4426950408889634f * z)); }

__device__ __forceinline__ void p0_transpose_item(const float* W, int K, int N, bf16* WT, bool up_perm, LAS float* scr, int item, int lane) {
    const int nblk = N / 32, kb = item / nblk, nb = item % nblk, k0 = 64 * kb, n0 = 32 * nb;
#pragma unroll 8
    for (int i = 0; i < 32; ++i) { const int kk = 2 * i + (lane >> 5); scr[kk * 33 + (lane & 31)] = W[(size_t)(k0 + kk) * N + n0 + (lane & 31)]; }
    LDS_WAIT(); asm volatile("" ::: "memory");
    int rb = n0; if (up_perm) { const int hi = n0 >= FF ? 1 : 0, cc = n0 - hi * FF; rb = (cc >> 7) * 256 + hi * 128 + (cc & 127); }
    const int c = lane & 7;
#pragma unroll
    for (int j = 0; j < 4; ++j) { const int n = (lane >> 3) + 8 * j; const LAS float* s = scr + (8 * c) * 33 + n;
        v4u o; o.x = pk2(s[0 * 33], s[1 * 33]); o.y = pk2(s[2 * 33], s[3 * 33]); o.z = pk2(s[4 * 33], s[5 * 33]); o.w = pk2(s[6 * 33], s[7 * 33]);
        *(v4u*)(WT + (size_t)(rb + n) * K + k0 + 8 * c) = o; }
    LDS_WAIT(); asm volatile("" ::: "memory");
}

struct P {
    const float *xp, *xs, *st_h, *st_conv, *st_ffn, *g_pre1, *w_in, *w_conv_a, *b_conv_a, *w_r, *b_r, *w_i, *b_i, *lam, *g_out_a, *g_v, *b_v, *w_s, *b_s, *g_out_b, *w_o, *g_post1, *g_pre2, *w_up,
                *w_conv_f, *b_conv_f, *w_down, *g_post2;
    float* out; unsigned char* ws;
};
__device__ __forceinline__ const float* xrow(const P& p, int m) { return m < MP ? p.xp + (size_t)m * D : p.xs + (size_t)(m - MP) * D; }

__device__ __forceinline__ void row_pre1(const P& p, int m, int lane) {
    const f32x4* xr = (const f32x4*)xrow(p, m) + lane; const f32x4* gr = (const f32x4*)p.g_pre1 + lane;
    f32x4 v[4]; float s = 0.f;
#pragma unroll
    for (int j = 0; j < 4; ++j) { v[j] = xr[64 * j]; s += (v[j].x * v[j].x + v[j].y * v[j].y) + (v[j].z * v[j].z + v[j].w * v[j].w); }
    const float rs = 1.0f / sqrtf(wave_sum(s) * (1.f / D) + EPS);
    unsigned long long* o8 = (unsigned long long*)((bf16*)(p.ws + WS_XN) + (size_t)m * D) + lane;
#pragma unroll
    for (int j = 0; j < 4; ++j) { const f32x4 g = gr[64 * j]; o8[64 * j] = (unsigned long long)pk2(v[j].x * rs * g.x, v[j].y * rs * g.y) | ((unsigned long long)pk2(v[j].z * rs * g.z, v[j].w * rs * g.w) << 32); }
}
__device__ __forceinline__ void row_post1(const P& p, int m, int lane) {
    const f32x4* xr = (const f32x4*)xrow(p, m) + lane; f32x4* yr = (f32x4*)(p.out + O_Y + (size_t)m * D) + lane;
    const f32x4* g1 = (const f32x4*)p.g_post1 + lane; const f32x4* g2 = (const f32x4*)p.g_pre2 + lane;
    f32x4 y[4]; float s = 0.f;
#pragma unroll
    for (int j = 0; j < 4; ++j) { y[j] = yr[64 * j]; s += (y[j].x * y[j].x + y[j].y * y[j].y) + (y[j].z * y[j].z + y[j].w * y[j].w); }
    const float rs = 1.0f / sqrtf(wave_sum(s) * (1.f / D) + EPS); float s2 = 0.f;
#pragma unroll
    for (int j = 0; j < 4; ++j) { y[j] = xr[64 * j] + y[j] * rs * g1[64 * j]; yr[64 * j] = y[j]; s2 += (y[j].x * y[j].x + y[j].y * y[j].y) + (y[j].z * y[j].z + y[j].w * y[j].w); }
    const float rs2 = 1.0f / sqrtf(wave_sum(s2) * (1.f / D) + EPS);
    unsigned long long* o8 = (unsigned long long*)((bf16*)(p.ws + WS_XN) + (size_t)m * D) + lane;
    unsigned long long* b8 = nullptr;
    if (m < MP - 64 && (m & 63) >= 62) b8 = (unsigned long long*)((bf16*)(p.ws + WS_XNB) + (size_t)(2 * ((m >> 6) + 1) + (m & 63) - 62) * D) + lane;
#pragma unroll
    for (int j = 0; j < 4; ++j) { const f32x4 g = g2[64 * j]; const unsigned long long w = (unsigned long long)pk2(y[j].x * rs2 * g.x, y[j].y * rs2 * g.y) | ((unsigned long long)pk2(y[j].z * rs2 * g.z, y[j].w * rs2 * g.w) << 32);
        o8[64 * j] = w; if (b8) b8[64 * j] = w; }
}
__device__ __forceinline__ void row_post2(const P& p, int m, int lane) {
    const f32x4* fr = (const f32x4*)((const float*)(p.ws + WS_F) + (size_t)m * D) + lane; f32x4* yr = (f32x4*)(p.out + O_Y + (size_t)m * D) + lane;
    const f32x4* g1 = (const f32x4*)p.g_post2 + lane;
    f32x4 y[4]; float s = 0.f;
#pragma unroll
    for (int j = 0; j < 4; ++j) { y[j] = fr[64 * j]; s += (y[j].x * y[j].x + y[j].y * y[j].y) + (y[j].z * y[j].z + y[j].w * y[j].w); }
    const float rs = 1.0f / sqrtf(wave_sum(s) * (1.f / D) + EPS);
#pragma unroll
    for (int j = 0; j < 4; ++j) yr[64 * j] = yr[64 * j] + y[j] * rs * g1[64 * j];
}

constexpr int MA_WL = 10752, MA_YS = 8 * MA_WL;
template <bool FINAL>
__device__ __forceinline__ void mixer_a_item(const P& p, LAS unsigned char* lds, int q, int wave, int lane) {
    const bool smp = q >= 256; const int b = q >> 5, cc = q & 31, sidx = q - 256;
    const int row0 = smp ? MP + sidx * SSEQ : b * SEQ + cc * 64;
    const int c = wave * 64 + lane;
    const bf16* Z = (const bf16*)(p.ws + WS_Z);
    float* AGG = (float*)(p.ws + WS_AGG);
    LAS unsigned char* wl = lds + wave * MA_WL;
    LAS bf16* XC = (LAS bf16*)wl;
    LAS float* RB = (LAS float*)(wl + 2560);
    LAS float* IB = (LAS float*)(wl + 2560 + 4096);
    LAS float* YS = (LAS float*)(lds + MA_YS);
    bf16x8 BR[2][4], BI[2][4];
    { const bf16x8* wf = (const bf16x8*)(p.ws + WS_WRF) + (size_t)wave * 8 * 64 + lane;
#pragma unroll
      for (int ks = 0; ks < 2; ++ks)
#pragma unroll
        for (int nt = 0; nt < 4; ++nt) { BR[ks][nt] = wf[(ks * 4 + nt) * 64]; BI[ks][nt] = wf[(size_t)8 * 8 * 64 + (ks * 4 + nt) * 64]; } }
    const float cw0 = p.w_conv_a[c], cw1 = p.w_conv_a[DA + c], cw2 = p.w_conv_a[2 * DA + c], cw3 = p.w_conv_a[3 * DA + c], cb = p.b_conv_a[c];
    const float br = p.b_r[c], bi = p.b_i[c];
    const float m8sp = -8.0f * log1pf(expf(-p.lam[c]));
    float xm3, xm2, xm1, h;
    if (smp) { const float* sc = p.st_conv + (size_t)sidx * 3 * DA; xm3 = sc[c]; xm2 = sc[DA + c]; xm1 = sc[2 * DA + c]; h = FINAL ? p.st_h[(size_t)sidx * DA + c] : 0.f; }
    else if (cc == 0) { xm3 = xm2 = xm1 = 0.f; h = 0.f; }
    else { const bf16* zp = Z + (size_t)(row0 - 3) * DIN + DA + c; xm3 = bf2f(zp[0]); xm2 = bf2f(zp[DIN]); xm1 = bf2f(zp[2 * DIN]); h = 0.f;
        if (FINAL) { const float* ag = AGG + (size_t)(b * 32) * 2 * DA + c; for (int k = 0; k < cc; ++k) h = ag[(size_t)k * 2 * DA] * h + ag[(size_t)k * 2 * DA + DA]; } }
    const bool first = !smp && cc == 0;
    float slog = 0.f;
    bf16* MIX = (bf16*)(p.ws + WS_MIX);
    const f32x4 ga = *(const f32x4*)(p.g_out_a + lane * 8), gb = *(const f32x4*)(p.g_out_a + lane * 8 + 4);
#pragma unroll 1
    for (int sc = 0; sc < 4; ++sc) {
        float xc[16];
        const bf16* zr = Z + (size_t)(row0 + sc * 16) * DIN + c;
#pragma unroll
        for (int tt = 0; tt < 16; ++tt) { const float xin = bf2f(zr[(size_t)tt * DIN + DA]);
            const float v = cb + cw0 * xm3 + cw1 * xm2 + cw2 * xm1 + cw3 * xin; xm3 = xm2; xm2 = xm1; xm1 = xin; xc[tt] = v; XC[tt * 72 + lane] = (bf16)f2bf(v); }
        LDS_WAIT();
        const bf16x8 a0 = *(const LAS bf16x8*)(XC + (lane & 15) * 72 + (lane >> 4) * 8), a1 = *(const LAS bf16x8*)(XC + (lane & 15) * 72 + 32 + (lane >> 4) * 8);
#pragma unroll
        for (int nt = 0; nt < 4; ++nt) { pg8::f32x4 ar = {0.f, 0.f, 0.f, 0.f}, ai = {0.f, 0.f, 0.f, 0.f};
            ar = __builtin_amdgcn_mfma_f32_16x16x32_bf16(a0, BR[0][nt], ar, 0, 0, 0); ar = __builtin_amdgcn_mfma_f32_16x16x32_bf16(a1, BR[1][nt], ar, 0, 0, 0);
            ai = __builtin_amdgcn_mfma_f32_16x16x32_bf16(a0, BI[0][nt], ai, 0, 0, 0); ai = __builtin_amdgcn_mfma_f32_16x16x32_bf16(a1, BI[1][nt], ai, 0, 0, 0);
#pragma unroll
            for (int r = 0; r < 4; ++r) { RB[((lane >> 4) * 4 + r) * 64 + nt * 16 + (lane & 15)] = ar[r]; IB[((lane >> 4) * 4 + r) * 64 + nt * 16 + (lane & 15)] = ai[r]; } }
        LDS_WAIT();
        if (FINAL && sc > 0) __syncthreads();
#pragma unroll
        for (int tt = 0; tt < 16; ++tt) {
            const float rg = sigmoidf_(RB[tt * 64 + lane] + br), ig = sigmoidf_(IB[tt * 64 + lane] + bi);
            const float la = m8sp * rg; const float a = __builtin_amdgcn_exp2f(1.4426950408889634f * la);
            float mult = sqrtf(-expm1f(2.0f * la)); if (first && sc == 0 && tt == 0) mult = 1.0f;
            h = a * h + mult * (ig * xc[tt]); slog += la;
            if (FINAL) { const float g = bf2f(zr[(size_t)tt * DIN]); YS[tt * DA + c] = h * pg8::gelu_tanh(g); }
        }
        LDS_WAIT();
        if (FINAL) {
            __syncthreads();
#pragma unroll
            for (int tj = 0; tj < 2; ++tj) { const int t = wave * 2 + tj;
                const f32x4 va = *(const LAS f32x4*)(YS + t * DA + lane * 8), vb = *(const LAS f32x4*)(YS + t * DA + lane * 8 + 4);
                const float ss = wave_sum((va.x * va.x + va.y * va.y) + (va.z * va.z + va.w * va.w) + (vb.x * vb.x + vb.y * vb.y) + (vb.z * vb.z + vb.w * vb.w));
                const float rs = 1.0f / sqrtf(ss * (1.f / DA) + EPS);
                v4u o; o.x = pk2(va.x * rs * ga.x, va.y * rs * ga.y); o.y = pk2(va.z * rs * ga.z, va.w * rs * ga.w); o.z = pk2(vb.x * rs * gb.x, vb.y * rs * gb.y); o.w = pk2(vb.z * rs * gb.z, vb.w * rs * gb.w);
                *(v4u*)(MIX + (size_t)(row0 + sc * 16 + t) * D + lane * 8) = o; }
            LDS_WAIT();
        }
    }
    if (!FINAL) { AGG[(size_t)q * 2 * DA + c] = expf(slog); AGG[(size_t)q * 2 * DA + DA + c] = h; return; }
    if (smp || cc == 31) {
        float* oh = smp ? p.out + O_HS + (size_t)sidx * DA : p.out + O_HP + (size_t)b * DA; oh[c] = h;
        float* oc = smp ? p.out + O_CS + (size_t)sidx * 3 * DA : p.out + O_CP + (size_t)b * 3 * DA; oc[c] = xm3; oc[DA + c] = xm2; oc[2 * DA + c] = xm1;
    }
    __syncthreads();
}

constexpr int VP = 132;
__device__ __forceinline__ void mixer_b_item(const P& p, LAS unsigned char* lds, int k, int wave, int lane) {
    const bool smp = k >= 128; const int sidx = k - 128; const int L = smp ? 64 : 128; const int row0 = smp ? MP + sidx * SSEQ : k * 128;
    const bf16* Z = (const bf16*)(p.ws + WS_Z);
    LAS bf16* VNt = (LAS bf16*)lds;
    const int RW = L / 8;
    {
    float gv[8], bv[8];
#pragma unroll
    for (int e = 0; e < 8; ++e) { gv[e] = p.g_v[e * 64 + lane]; bv[e] = p.b_v[e * 64 + lane]; }
#pragma unroll 1
    for (int jj = 0; jj < RW; ++jj) { const int j = wave * RW + jj; const bf16* zr = Z + (size_t)(row0 + j) * DIN + 3 * DA;
        float v[8]; float s = 0.f;
#pragma unroll
        for (int e = 0; e < 8; ++e) { v[e] = bf2f(zr[e * 64 + lane]); s += v[e]; }
        const float mu = wave_sum(s) * (1.f / DB); float s2 = 0.f;
#pragma unroll
        for (int e = 0; e < 8; ++e) { v[e] -= mu; s2 += v[e] * v[e]; }
        const float rstd = 1.0f / sqrtf(wave_sum(s2) * (1.f / DB) + EPS);
#pragma unroll
        for (int e = 0; e < 8; ++e) { const float vn = v[e] * rstd * gv[e] + bv[e]; VNt[(e * 64 + lane) * VP + j] = (bf16)f2bf(vn);
            if (smp) p.out[O_VS + ((size_t)sidx * SSEQ + j) * DB + e * 64 + lane] = vn; }
    }
    }
    __syncthreads();
    if (wave * 16 < L) {
        const int i0 = wave * 16, nks = (smp || i0 < 64) ? 2 : 4;
        const int il = lane & 15, kg = lane >> 4; const int row = row0 + i0 + il;
        bf16* MIX = (bf16*)(p.ws + WS_MIX);
        float ss = 0.f, rs = 0.f;
#pragma unroll 1
        for (int pass = 0; pass < 2; ++pass) {
#pragma unroll 1
            for (int hh = 0; hh < 4; ++hh) {
                bf16x8 wf[4];
#pragma unroll
                for (int ks = 0; ks < 4; ++ks) { wf[ks] = (bf16x8){0, 0, 0, 0, 0, 0, 0, 0};
                    if (ks < nks) { const float* wp = p.w_s + ((size_t)hh * 128 + i0 + il) * 128 + ks * 32 + kg * 8; const f32x4 w0 = *(const f32x4*)wp, w1 = *(const f32x4*)(wp + 4);
                        wf[ks][0] = (short)f2bf(w0.x); wf[ks][1] = (short)f2bf(w0.y); wf[ks][2] = (short)f2bf(w0.z); wf[ks][3] = (short)f2bf(w0.w);
                        wf[ks][4] = (short)f2bf(w1.x); wf[ks][5] = (short)f2bf(w1.y); wf[ks][6] = (short)f2bf(w1.z); wf[ks][7] = (short)f2bf(w1.w); } }
                const float bs = p.b_s[hh * 128 + i0 + il];
#pragma unroll 2
                for (int dt = 0; dt < 8; ++dt) { pg8::f32x4 a = {0.f, 0.f, 0.f, 0.f};
#pragma unroll
                    for (int ks = 0; ks < 4; ++ks) if (ks < nks) { const LAS bf16* vp = VNt + (hh * 128 + dt * 16 + il) * VP + ks * 32 + kg * 8;
                        typedef short s16x4 __attribute__((ext_vector_type(4)));
                        const s16x4 lo = *(const LAS s16x4*)vp, hi = *(const LAS s16x4*)(vp + 4);
                        const bf16x8 af = {lo[0], lo[1], lo[2], lo[3], hi[0], hi[1], hi[2], hi[3]};
                        a = __builtin_amdgcn_mfma_f32_16x16x32_bf16(af, wf[ks], a, 0, 0, 0); }
                    const int d0 = hh * 128 + dt * 16 + kg * 4; const pg8::f32x4 u4 = pg8::bf4_to_f4(Z + (size_t)row * DIN + 2 * DA + d0);
                    const pg8::f32x4 yv = u4 * (a + bs);
                    if (pass == 0) ss += (yv[0] * yv[0] + yv[1] * yv[1]) + (yv[2] * yv[2] + yv[3] * yv[3]);
                    else { const f32x4 g = *(const f32x4*)(p.g_out_b + d0);
                        v2u o; o.x = pk2(yv[0] * rs * g.x, yv[1] * rs * g.y); o.y = pk2(yv[2] * rs * g.z, yv[3] * rs * g.w);
                        *(v2u*)(MIX + (size_t)row * D + DA + d0) = o; }
                }
            }
            if (pass == 0) { ss += __shfl_xor(ss, 16); ss += __shfl_xor(ss, 32); rs = 1.0f / sqrtf(ss * (1.f / DB) + EPS); }
        }
    }
    __syncthreads();
}


struct Args { const float* in[28]; float* out; unsigned char* ws; int ph_lo, ph_hi; };
constexpr int NPH = 10;
__global__ void __launch_bounds__(512, 2) fwd(Args args) {
    extern __shared__ __attribute__((aligned(16))) unsigned char lds_raw[];
    LAS unsigned char* lds = (LAS unsigned char*)lds_raw;
    cg::grid_group grid = cg::this_grid();
    const int tid = threadIdx.x, lane = tid & 63, wave = __builtin_amdgcn_readfirstlane(tid >> 6);
    const int G = gridDim.x, bx = blockIdx.x;
    const int gw = bx * 8 + wave, NGW = G * 8;
    P p;
    p.xp = args.in[0]; p.xs = args.in[1]; p.st_h = args.in[2]; p.st_conv = args.in[3]; p.st_ffn = args.in[4]; p.g_pre1 = args.in[5]; p.w_in = args.in[6]; p.w_conv_a = args.in[7]; p.b_conv_a = args.in[8];
    p.w_r = args.in[9]; p.b_r = args.in[10]; p.w_i = args.in[11]; p.b_i = args.in[12]; p.lam = args.in[13]; p.g_out_a = args.in[14]; p.g_v = args.in[15]; p.b_v = args.in[16]; p.w_s = args.in[17]; p.b_s = args.in[18];
    p.g_out_b = args.in[19]; p.w_o = args.in[20]; p.g_post1 = args.in[21]; p.g_pre2 = args.in[22]; p.w_up = args.in[23]; p.w_conv_f = args.in[24]; p.b_conv_f = args.in[25]; p.w_down = args.in[26]; p.g_post2 = args.in[27];
    p.out = args.out; p.ws = args.ws;
    unsigned char* ws = args.ws;
    bf16 *Wt_in = (bf16*)(ws + WS_WIN), *Wt_o = (bf16*)(ws + WS_WO), *Wt_up = (bf16*)(ws + WS_WUP), *Wt_dn = (bf16*)(ws + WS_WDN);
    bf16 *XN = (bf16*)(ws + WS_XN), *Zb = (bf16*)(ws + WS_Z), *MIX = (bf16*)(ws + WS_MIX), *HB = (bf16*)(ws + WS_HB), *XNB = (bf16*)(ws + WS_XNB), *UB = (bf16*)(ws + WS_UB);
    float* Fb = (float*)(ws + WS_F);
    const int lo = args.ph_lo, hi = args.ph_hi;
#ifndef PHASE_MASK
#define PHASE_MASK 0x3ff
#endif
#define IN(k) ((((PHASE_MASK) >> (k)) & 1) && lo <= (k) && (k) < hi)
#define SEAM(k) do { if (IN(k) && IN((k) + 1)) grid.sync(); } while (0)

    if (IN(0)) {
        LAS float* scr = (LAS float*)(lds + wave * 16384);
        constexpr int I_IN = (D / 64) * (DIN / 32), I_O = (D / 64) * (D / 32), I_UP = (D / 64) * (FF2 / 32), I_DN = (FF / 64) * (D / 32);
        for (int it = gw; it < I_IN + I_O + I_UP + I_DN; it += NGW) { int r = it;
            if (r < I_IN) { p0_transpose_item(p.w_in, D, DIN, Wt_in, false, scr, r, lane); continue; } r -= I_IN;
            if (r < I_O) { p0_transpose_item(p.w_o, D, D, Wt_o, false, scr, r, lane); continue; } r -= I_O;
            if (r < I_UP) { p0_transpose_item(p.w_up, D, FF2, Wt_up, true, scr, r, lane); continue; } r -= I_UP;
            p0_transpose_item(p.w_down, FF, D, Wt_dn, false, scr, r, lane); }
        for (int idx = bx * 512 + tid; idx < 2 * 8 * 8 * 64 * 8; idx += G * 512) { const int j = idx & 7, ln = (idx >> 3) & 63, f = (idx >> 9) & 7, hh = (idx >> 12) & 7, mat = idx >> 15;
            const int d = (f >> 2) * 32 + (ln >> 4) * 8 + j, e = (f & 3) * 16 + (ln & 15);
            ((bf16*)(ws + WS_WRF))[idx] = (bf16)f2bf((mat ? p.w_i : p.w_r)[(size_t)hh * 4096 + d * 64 + e]); }
        for (int m = gw; m < M; m += NGW) row_pre1(p, m, lane);
        __syncthreads();
    }
    SEAM(0);
    if (IN(1)) { pg8::Gemm g{XN, Wt_in, M, DIN, D}; pg8::StaticOrder S; S.init(M, DIN, G, bx);
        pg8::EpiBf16<0> E{Zb, DIN, nullptr, 0, 0, 1.f};
        pg8::gemm_phase<pg8::EpiBf16<0>, pg8::StaticOrder, true, true>(lds, g, S, E); }
    SEAM(1);
    if (IN(2)) { for (int it = bx; it < NB * 31; it += G) { const int q = (it / 31) * 32 + it % 31; mixer_a_item<false>(p, lds, q, wave, lane); } }
    SEAM(2);
    if (IN(3)) { for (int it = bx; it < 272 + 144; it += G) { if (it < 272) mixer_a_item<true>(p, lds, it, wave, lane); else mixer_b_item(p, lds, it - 272, wave, lane); } }
    SEAM(3);
    if (IN(4)) { pg8::Gemm g{MIX, Wt_o, M, D, D}; pg8::StaticOrder S; S.init(M, D, G, bx);
        pg8::EpiF32 E{p.out + O_Y, D, nullptr};
        pg8::gemm_phase<pg8::EpiF32, pg8::StaticOrder, true, true>(lds, g, S, E); }
    SEAM(4);
    if (IN(5)) { for (int m = gw; m < M; m += NGW) row_post1(p, m, lane); }
    SEAM(5);
    if (IN(6)) { pg8::Gemm g{XNB, Wt_up, 512, FF2, D}; pg8::StaticOrder S; S.init(512, FF2, G, bx);
        pg8::EpiBf16<0> E{UB, FF2, nullptr, 0, 0, 1.f};
        pg8::gemm_phase<pg8::EpiBf16<0>, pg8::StaticOrder, true, true>(lds, g, S, E); }
    SEAM(6);
    if (IN(7)) { pg8::Gemm g{XN, Wt_up, M, FF2, D}; pg8::StaticOrder S; S.init(M, FF2, G, bx);
        pg8::EpiConvGeglu E{HB, UB, p.st_ffn, p.w_conv_f, p.b_conv_f, p.out + O_FP, p.out + O_FS};
        pg8::gemm_phase<pg8::EpiConvGeglu, pg8::StaticOrder, true, true>(lds, g, S, E); }
    SEAM(7);
    if (IN(8)) { pg8::Gemm g{HB, Wt_dn, M, D, FF}; pg8::StaticOrder S; S.init(M, D, G, bx);
        pg8::EpiF32 E{Fb, D, nullptr};
        pg8::gemm_phase<pg8::EpiF32, pg8::StaticOrder, true, true>(lds, g, S, E); }
    SEAM(8);
    if (IN(9)) { for (int m = gw; m < M; m += NGW) row_post2(p, m, lane); }
#undef IN
#undef SEAM
}

extern "C" void kernel_launch(void* const* d_in, const int* in_sizes, int n_in, void* d_out, int out_size, void* d_ws, size_t ws_size, hipStream_t stream) {
    static int grid = 0;
    if (grid == 0) {
        if (n_in != 28 || (size_t)out_size != O_END || ws_size < WS_END) { fprintf(stderr, "kernel_launch: unexpected shapes: n_in %d out %d ws %zu\n", n_in, out_size, ws_size); grid = -1; return; }
        int dev = 0, cus = 0, per_cu = 0;
        if (hipGetDevice(&dev) != hipSuccess || hipDeviceGetAttribute(&cus, hipDeviceAttributeMultiprocessorCount, dev) != hipSuccess) { grid = -1; return; }
        if (hipFuncSetAttribute((const void*)fwd, hipFuncAttributeMaxDynamicSharedMemorySize, LDS_BYTES) != hipSuccess) { fprintf(stderr, "kernel_launch: hipFuncSetAttribute failed\n"); grid = -1; return; }
        if (hipOccupancyMaxActiveBlocksPerMultiprocessor(&per_cu, (const void*)fwd, 512, LDS_BYTES) != hipSuccess || per_cu < 1) { fprintf(stderr, "kernel_launch: occupancy query failed (%d)\n", per_cu); (void)hipGetLastError(); per_cu = 1; }
        grid = cus * 1;
        if (grid > 256) grid = 256;
    }
    if (grid < 0) return;
    Args a{};
    for (int i = 0; i < 28; ++i) a.in[i] = (const float*)d_in[i];
    a.out = (float*)d_out; a.ws = (unsigned char*)d_ws; a.ph_lo = 0; a.ph_hi = NPH;
    void* kargs[] = {&a};
    const hipError_t e = hipLaunchCooperativeKernel((const void*)fwd, dim3(grid), dim3(512), kargs, LDS_BYTES, stream);
    if (e != hipSuccess) fprintf(stderr, "kernel_launch: cooperative launch failed: %s (grid %d)\n", hipGetErrorString(e), grid);
}
```

```cpp
#include <hip/hip_runtime.h>
#include <cstdio>
#include <cstdint>
namespace pg8 {
#define PG8_LAS __attribute__((address_space(3)))
typedef unsigned short bf16_t;
typedef short bf16x8 __attribute__((ext_vector_type(8)));
typedef float f32x4 __attribute__((ext_vector_type(4)));
typedef unsigned u32x4 __attribute__((ext_vector_type(4)));
constexpr int BM = 256, BK = 64, HALF = 128, HTB = HALF * BK * 2  , STAGE_BYTES = 8 * HTB, NXCD = 8, WGM = 8;

__host__ __device__ __forceinline__ int lds_byte(int r, int c) { const int st = (r >> 4) * 2 + (c >> 5), rr = r & 15, cc = c & 31, ob = rr * 64 + cc * 2; return st * 1024 + (ob ^ (((ob >> 9) & 1) << 5)); }
__host__ __device__ __forceinline__ void stage_rc(int b, int& R, int& C) { const int st = b / 1024, sb = b % 1024, swz = sb ^ (((sb >> 9) & 1) << 5); R = (st >> 1) * 16 + swz / 64; C = (st & 1) * 32 + (swz % 64) / 2; }
__host__ __device__ __forceinline__ int perm32(int rho) { const int n = rho >> 4, i = rho & 15; return 8 * (i >> 2) + 4 * n + (i & 3); }

struct Unit { int pm, pn; };
struct Gemm { const bf16_t* A; const bf16_t* Bt; int M, N, K; };

struct StaticOrder {
    int nM, nN, nwg, G, c;
    __host__ __device__ void init(int M, int N, int G_, int c_) { nM = M / BM; nN = N / BM; nwg = nM * nN; G = G_; c = c_; }
    __host__ __device__ bool next(int i, Unit& u) const {
        const long L = (long)i * G + c; if (L >= nwg) return false;
        int wgid = (int)L; { const int q = nwg / NXCD, r = nwg % NXCD, xcd = wgid % NXCD, off = wgid / NXCD; wgid = (xcd < r ? xcd * (q + 1) : r * (q + 1) + (xcd - r) * q) + off; }
        const int nig = WGM * nN, gid = wgid / nig, fm = gid * WGM, gsz = (nM - fm) < WGM ? (nM - fm) : WGM;
        u.pm = fm + ((wgid % nig) % gsz); u.pn = (wgid % nig) / gsz; return true;
    }
    __device__ __forceinline__ void a_ready(const Unit&) const {}
    __device__ __forceinline__ void done(const Unit&) const {}
};

__device__ __forceinline__ unsigned cvt_pk_bf16(float lo, float hi) { unsigned r; asm volatile("v_cvt_pk_bf16_f32 %0, %1, %2" : "=v"(r) : "v"(lo), "v"(hi)); return r; }
typedef float f32x2 __attribute__((ext_vector_type(2)));
__device__ __forceinline__ f32x2 gelu_pk(f32x2 v) {
    const f32x2 av = __builtin_elementwise_abs(v), d = av * 0.2316418882f + 1.0f;
    f32x2 t; t.x = __builtin_amdgcn_rcpf(d.x); t.y = __builtin_amdgcn_rcpf(d.y);
    f32x2 q = t * 0.5307027145f + (-0.7265760135f); q = q * t + 0.7107068705f; q = q * t + (-0.142248368f); q = q * t + 0.127414796f; q = q * t;
    const f32x2 s = (v * v) * (-0.72134752044f);
    f32x2 e; e.x = __builtin_amdgcn_exp2f(s.x); e.y = __builtin_amdgcn_exp2f(s.y);
    const f32x2 m = v * (q * e), r = v - m;
    f32x2 o; o.x = v.x < 0.f ? m.x : r.x; o.y = v.y < 0.f ? m.y : r.y; return o;
}

template <int ACT  > struct EpiBf16 {
    static constexpr bool PERM = true, AFTER_DRAIN = false; static_assert(ACT == 0 || ACT == 1, "EpiBf16: ACT is 0 (none) or 1 (gelu_pk)");
    bf16_t* O; int ldc; const float* bias; int split_cols; size_t split_stride; float scale0;
    __device__ __forceinline__ void operator()(const f32x4 (&acc)[2][2][4][2], const Unit& u, int wr, int wc, int fr, int fq) const {
        const int row0 = u.pm * BM + wr * 64 + fr; int colt = u.pn * BM; bf16_t* base = O;
        float sc = 1.f; if (split_cols) { const int t = colt / split_cols; base += (size_t)t * split_stride; colt -= t * split_cols; if (t == 0) sc = scale0; }
        const int col0 = colt + wc * 32 + 8 * fq, bcol0 = u.pn * BM + wc * 32 + 8 * fq;
        f32x4 bv[2][2];
#pragma unroll
        for (int bj = 0; bj < 2; ++bj)
#pragma unroll
            for (int n = 0; n < 2; ++n) bv[bj][n] = bias ? *(const f32x4*)(bias + bcol0 + bj * HALF + 4 * n) : (f32x4){0.f, 0.f, 0.f, 0.f};
#pragma unroll
        for (int ai = 0; ai < 2; ++ai)
#pragma unroll
            for (int m = 0; m < 4; ++m) { bf16_t* rowp = base + (size_t)(row0 + ai * HALF + m * 16) * ldc + col0;
#pragma unroll
                for (int bj = 0; bj < 2; ++bj) { f32x4 v0 = acc[ai][bj][m][0] + bv[bj][0], v1 = acc[ai][bj][m][1] + bv[bj][1];
                    if (ACT == 1) { f32x2 a = gelu_pk((f32x2){v0[0], v0[1]}), b = gelu_pk((f32x2){v0[2], v0[3]}), c = gelu_pk((f32x2){v1[0], v1[1]}), d = gelu_pk((f32x2){v1[2], v1[3]});
                        v0 = (f32x4){a.x, a.y, b.x, b.y}; v1 = (f32x4){c.x, c.y, d.x, d.y}; }
                    v0 = v0 * sc; v1 = v1 * sc; u32x4 w; w.x = cvt_pk_bf16(v0[0], v0[1]); w.y = cvt_pk_bf16(v0[2], v0[3]); w.z = cvt_pk_bf16(v1[0], v1[1]); w.w = cvt_pk_bf16(v1[2], v1[3]);
                    *(u32x4*)(rowp + bj * HALF) = w; } }
    }
};
struct EpiF32 {
    static constexpr bool PERM = false, AFTER_DRAIN = false;
    float* C; int ldc; const float* bias;
    __device__ __forceinline__ void operator()(const f32x4 (&acc)[2][2][4][2], const Unit& u, int wr, int wc, int fr, int fq) const {
        const int row0 = u.pm * BM + wr * 64 + fr, col0 = u.pn * BM + wc * 32 + 4 * fq;
        f32x4 bv[2][2];
#pragma unroll
        for (int bj = 0; bj < 2; ++bj)
#pragma unroll
            for (int n = 0; n < 2; ++n) bv[bj][n] = bias ? *(const f32x4*)(bias + col0 + bj * HALF + n * 16) : (f32x4){0.f, 0.f, 0.f, 0.f};
#pragma unroll
        for (int ai = 0; ai < 2; ++ai)
#pragma unroll
            for (int m = 0; m < 4; ++m) { float* rowp = C + (size_t)(row0 + ai * HALF + m * 16) * ldc + col0;
#pragma unroll
                for (int bj = 0; bj < 2; ++bj)
#pragma unroll
                    for (int n = 0; n < 2; ++n) *(f32x4*)(rowp + bj * HALF + n * 16) = acc[ai][bj][m][n] + bv[bj][n]; }
    }
};
__device__ __forceinline__ float dpp_shr1(float old, float src) { return __builtin_bit_cast(float, __builtin_amdgcn_update_dpp(__builtin_bit_cast(int, old), __builtin_bit_cast(int, src), 0x111, 0xf, 0xf, false)); }
__device__ __forceinline__ float dpp_shr2(float old, float src) { return __builtin_bit_cast(float, __builtin_amdgcn_update_dpp(__builtin_bit_cast(int, old), __builtin_bit_cast(int, src), 0x112, 0xf, 0xf, false)); }
__device__ __forceinline__ float dpp_ror1(float src) { return __builtin_bit_cast(float, __builtin_amdgcn_update_dpp(0, __builtin_bit_cast(int, src), 0x121, 0xf, 0xf, false)); }
__device__ __forceinline__ float dpp_ror2(float src) { return __builtin_bit_cast(float, __builtin_amdgcn_update_dpp(0, __builtin_bit_cast(int, src), 0x122, 0xf, 0xf, false)); }
__device__ __forceinline__ float gelu_tanh(float x) {
    const float t = x * x, inner = x * (2.302208198f + 0.102943240f * t);
    return x * __builtin_amdgcn_rcpf(1.0f + __builtin_amdgcn_exp2f(-inner));
}
__device__ __forceinline__ f32x4 bf4_to_f4(const bf16_t* p) { const unsigned long long w = *(const unsigned long long*)p;
    return (f32x4){__builtin_bit_cast(float, (unsigned)(w << 16)), __builtin_bit_cast(float, (unsigned)w & 0xffff0000u), __builtin_bit_cast(float, (unsigned)(w >> 32) << 16), __builtin_bit_cast(float, (unsigned)(w >> 32) & 0xffff0000u)}; }

struct EpiConvGeglu {
    static constexpr bool PERM = true, AFTER_DRAIN = false;
    bf16_t* HB;
    const bf16_t* UB;
    const float* state;
    const float* wcv;
    const float* bcv;
    float* out_p;
    float* out_s;
    __device__ __forceinline__ void operator()(const f32x4 (&acc)[2][2][4][2], const Unit& u, int wr, int wc, int fr, int fq) const {
        const int cgb = u.pn * 128 + wc * 32 + 8 * fq;
        const int npb = u.pn * 256 + wc * 32 + 8 * fq;
#pragma unroll
        for (int n = 0; n < 2; ++n) {
            const int cg = cgb + 4 * n;
            const f32x4 w0g = *(const f32x4*)(wcv + cg), w1g = *(const f32x4*)(wcv + 6144 + cg), w2g = *(const f32x4*)(wcv + 12288 + cg), bg = *(const f32x4*)(bcv + cg);
            const f32x4 w0v = *(const f32x4*)(wcv + 3072 + cg), w1v = *(const f32x4*)(wcv + 6144 + 3072 + cg), w2v = *(const f32x4*)(wcv + 12288 + 3072 + cg), bv = *(const f32x4*)(bcv + 3072 + cg);
#pragma unroll
            for (int ai = 0; ai < 2; ++ai) {
                const int r0 = u.pm * BM + ai * HALF + wr * 64;
                f32x4 c1g, c2g, c1v, c2v;
                if (r0 >= 16384) { const float* st = state + (size_t)((r0 - 16384) >> 6) * 2 * 6144;
                    c2g = *(const f32x4*)(st + cg); c1g = *(const f32x4*)(st + 6144 + cg); c2v = *(const f32x4*)(st + 3072 + cg); c1v = *(const f32x4*)(st + 6144 + 3072 + cg); }
                else if ((r0 & 2047) == 0) { c1g = c2g = c1v = c2v = (f32x4){0.f, 0.f, 0.f, 0.f}; }
                else { const bf16_t* ub = UB + (size_t)(2 * (r0 >> 6)) * 6144 + npb + 4 * n;
                    c2g = bf4_to_f4(ub); c1g = bf4_to_f4(ub + 6144); c2v = bf4_to_f4(ub + 128); c1v = bf4_to_f4(ub + 6144 + 128); }
#pragma unroll
                for (int m = 0; m < 4; ++m) {
                    const f32x4 xg = acc[ai][0][m][n], xv = acc[ai][1][m][n];
                    f32x4 o1g, o2g, o1v, o2v;
                    if (m == 0) { o1g = c1g; o1v = c1v; o2g = (fr == 0) ? c2g : c1g; o2v = (fr == 0) ? c2v : c1v; }
                    else { const f32x4 pg = acc[ai][0][m > 0 ? m - 1 : 0][n], pv = acc[ai][1][m > 0 ? m - 1 : 0][n];
#pragma unroll
                        for (int e = 0; e < 4; ++e) { o1g[e] = dpp_ror1(pg[e]); o2g[e] = dpp_ror2(pg[e]); o1v[e] = dpp_ror1(pv[e]); o2v[e] = dpp_ror2(pv[e]); } }
                    float res[4];
#pragma unroll
                    for (int e = 0; e < 4; ++e) {
                        const float g1 = dpp_shr1(o1g[e], xg[e]), g2 = dpp_shr2(o2g[e], xg[e]);
                        const float v1 = dpp_shr1(o1v[e], xv[e]), v2 = dpp_shr2(o2v[e], xv[e]);
                        const float cgv = bg[e] + w0g[e] * g2 + w1g[e] * g1 + w2g[e] * xg[e];
                        const float cvv = bv[e] + w0v[e] * v2 + w1v[e] * v1 + w2v[e] * xv[e];
                        res[e] = gelu_tanh(cgv) * cvv;
                    }
                    typedef unsigned u32x2v __attribute__((ext_vector_type(2)));
                    u32x2v w; w.x = cvt_pk_bf16(res[0], res[1]); w.y = cvt_pk_bf16(res[2], res[3]);
                    *(u32x2v*)(HB + (size_t)(r0 + 16 * m + fr) * 3072 + cg) = w;
                }
                const bool smp = r0 >= 16384;
                if ((smp || (((r0 + 64) & 2047) == 0)) && fr >= 14) {
                    float* o = (smp ? out_s + (size_t)((r0 - 16384) >> 6) * 2 * 6144 : out_p + (size_t)(r0 >> 11) * 2 * 6144) + (fr - 14) * 6144;
                    *(f32x4*)(o + cg) = acc[ai][0][3][n]; *(f32x4*)(o + 3072 + cg) = acc[ai][1][3][n];
                }
            }
        }
    }
};
template <class Epi, class Sched, bool ALIGN_EPI = false, bool SP2 = false>
__device__ __forceinline__ void gemm_phase(PG8_LAS unsigned char* lds, const Gemm g, const Sched& S, const Epi& E) {
    const int tid = threadIdx.x, wid = __builtin_amdgcn_readfirstlane(tid >> 6), lane = tid & 63, wr = wid >> 2, wc = wid & 3, fr = lane & 15, fq = lane >> 4;
    const int K = g.K, nt = K / BK;
    unsigned voffA[2], voffB[2];
#pragma unroll
    for (int i = 0; i < 2; ++i) { int R, C; stage_rc(tid * 16 + i * 8192, R, C); const int Rb = Epi::PERM ? ((R & ~31) + perm32(R & 31)) : R;
        voffA[i] = (unsigned)(R * K + C) * 2u; voffB[i] = (unsigned)(Rb * K + C) * 2u; }
    const size_t kstep = (size_t)(BK * 2);
    const size_t hstep = (size_t)HALF * K * 2;
    const size_t tstep = 2 * hstep;
    const unsigned ldsw = (unsigned)wid * 1024u;
    const int aoff = lds_byte(wr * 64 + fr, fq * 8), boff = lds_byte(wc * 32 + fr, fq * 8);
#define PG8_SA(b, h) (((b) * 2 + (h)) * HTB)
#define PG8_SB(b, h) ((4 + (b) * 2 + (h)) * HTB)
#define PG8_STAGE(bufoff, gbase, voff) do { _Pragma("unroll") for (int _i = 0; _i < 2; ++_i) \
        __builtin_amdgcn_global_load_lds((const unsigned*)((const char*)(gbase) + (voff)[_i]), (PG8_LAS unsigned*)(lds + (bufoff) + ldsw + _i * 8192), 16, 0, 0); } while (0)
#define PG8_LDA(dst, b, h) do { _Pragma("unroll") for (int m = 0; m < 4; ++m) _Pragma("unroll") for (int k = 0; k < 2; ++k) dst[m][k] = *(const PG8_LAS bf16x8*)(lds + PG8_SA(b, h) + aoff + m * 2048 + k * 1024); } while (0)
#define PG8_LDB(dst, b, h) do { _Pragma("unroll") for (int n = 0; n < 2; ++n) _Pragma("unroll") for (int k = 0; k < 2; ++k) dst[n][k] = *(const PG8_LAS bf16x8*)(lds + PG8_SB(b, h) + boff + n * 2048 + k * 1024); } while (0)
#define PG8_MMA(ai, bj, At, Bt) do { __builtin_amdgcn_s_setprio(1); _Pragma("unroll") for (int m = 0; m < 4; ++m) _Pragma("unroll") for (int n = 0; n < 2; ++n) _Pragma("unroll") for (int k = 0; k < 2; ++k) \
        acc[ai][bj][m][n] = __builtin_amdgcn_mfma_f32_16x16x32_bf16(Bt[n][k], At[m][k], acc[ai][bj][m][n], 0, 0, 0); __builtin_amdgcn_s_setprio(0); } while (0)
#define PG8_WAIT_V(n) asm volatile("s_waitcnt vmcnt(" #n ")" ::: "memory")
#define PG8_WAIT_L(n) asm volatile("s_waitcnt lgkmcnt(" #n ")" ::: "memory")
#define PG8_BAR __builtin_amdgcn_s_barrier()
#define PG8_SCHED __builtin_amdgcn_sched_barrier(0)
    Unit cur, nxt; int ui = 0;
    if (!S.next(0, cur)) return;
    f32x4 acc[2][2][4][2];
#pragma unroll
    for (int a = 0; a < 2; ++a)
#pragma unroll
        for (int b = 0; b < 2; ++b)
#pragma unroll
            for (int m = 0; m < 4; ++m)
#pragma unroll
                for (int n = 0; n < 2; ++n) acc[a][b][m][n] = (f32x4){0.f, 0.f, 0.f, 0.f};
    bf16x8 At[4][2], B0[2][2], B1[2][2];
    const char* cA = (const char*)g.A + (size_t)cur.pm * tstep; const char* cB = (const char*)g.Bt + (size_t)cur.pn * tstep;
    S.a_ready(cur);
    if constexpr (SP2) {
        PG8_STAGE(PG8_SB(0, 0), cB, voffB); PG8_STAGE(PG8_SB(0, 1), cB + hstep, voffB); PG8_STAGE(PG8_SA(0, 0), cA, voffA); PG8_STAGE(PG8_SA(0, 1), cA + hstep, voffA);
        if (wr == 1) PG8_BAR;
        PG8_WAIT_V(2); PG8_BAR;
        PG8_STAGE(PG8_SB(1, 0), cB + kstep, voffB); PG8_STAGE(PG8_SA(1, 0), cA + kstep, voffA); PG8_STAGE(PG8_SB(1, 1), cB + hstep + kstep, voffB);
        PG8_WAIT_V(6); PG8_BAR;
    } else {
        PG8_STAGE(PG8_SB(0, 0), cB, voffB); PG8_STAGE(PG8_SA(0, 0), cA, voffA); PG8_STAGE(PG8_SB(0, 1), cB + hstep, voffB); PG8_STAGE(PG8_SA(0, 1), cA + hstep, voffA);
        if (wr == 1) PG8_BAR;
        PG8_WAIT_V(4); PG8_BAR;
        PG8_STAGE(PG8_SB(1, 0), cB + kstep, voffB); PG8_STAGE(PG8_SA(1, 0), cA + kstep, voffA); PG8_STAGE(PG8_SB(1, 1), cB + hstep + kstep, voffB);
        PG8_WAIT_V(6); PG8_BAR;
    }
    for (;;) {
        const bool has_next = S.next(ui + 1, nxt);
        const char* nA = has_next ? (const char*)g.A + (size_t)nxt.pm * tstep : cA; const char* nB = has_next ? (const char*)g.Bt + (size_t)nxt.pn * tstep : cB;
        for (int t = 0; t < nt; t += 2) {
            const bool last = (t == nt - 2);
            const char* a1 = cA + (size_t)(t + 1) * kstep;
            const char* a2 = last ? nA : cA + (size_t)(t + 2) * kstep; const char* b2 = last ? nB : cB + (size_t)(t + 2) * kstep;
            const char* a3 = a2 + kstep; const char* b3 = b2 + kstep;
            if (last && has_next) S.a_ready(nxt);
            if constexpr (SP2) {
            PG8_LDB(B0, 0, 0); PG8_LDB(B1, 0, 1); PG8_SCHED; PG8_LDA(At, 0, 0); PG8_STAGE(PG8_SA(1, 1), a1 + hstep, voffA);
            PG8_WAIT_V(8); PG8_WAIT_L(0); PG8_BAR; PG8_MMA(0, 0, At, B0); PG8_MMA(0, 1, At, B1); PG8_BAR; PG8_SCHED;
            PG8_LDA(At, 0, 1); PG8_STAGE(PG8_SB(0, 0), b2, voffB); PG8_STAGE(PG8_SB(0, 1), b2 + hstep, voffB); PG8_STAGE(PG8_SA(0, 0), a2, voffA);
            PG8_WAIT_V(8); PG8_WAIT_L(0); PG8_BAR; PG8_MMA(1, 0, At, B0); PG8_MMA(1, 1, At, B1); PG8_BAR; PG8_SCHED;
            PG8_LDB(B0, 1, 0); PG8_LDB(B1, 1, 1); PG8_SCHED; PG8_LDA(At, 1, 0); PG8_STAGE(PG8_SA(0, 1), a2 + hstep, voffA);
            PG8_WAIT_V(8); PG8_WAIT_L(0); PG8_BAR; PG8_MMA(0, 0, At, B0); PG8_MMA(0, 1, At, B1); PG8_BAR; PG8_SCHED;
            PG8_LDA(At, 1, 1); PG8_STAGE(PG8_SB(1, 0), b3, voffB); PG8_STAGE(PG8_SB(1, 1), b3 + hstep, voffB); PG8_STAGE(PG8_SA(1, 0), a3, voffA);
            PG8_WAIT_V(8); PG8_WAIT_L(0); PG8_BAR; PG8_MMA(1, 0, At, B0); PG8_MMA(1, 1, At, B1); PG8_BAR; PG8_SCHED;
            } else {
            PG8_LDB(B0, 0, 0); PG8_SCHED; PG8_LDA(At, 0, 0); PG8_STAGE(PG8_SA(1, 1), a1 + hstep, voffA);
            PG8_WAIT_L(8); PG8_BAR; PG8_WAIT_L(0); PG8_MMA(0, 0, At, B0); PG8_BAR; PG8_SCHED;
            PG8_LDB(B1, 0, 1); PG8_STAGE(PG8_SB(0, 0), b2, voffB);
            PG8_BAR; PG8_WAIT_L(0); PG8_MMA(0, 1, At, B1); PG8_BAR;
            PG8_LDA(At, 0, 1); PG8_STAGE(PG8_SA(0, 0), a2, voffA);
            PG8_BAR; PG8_WAIT_L(0); PG8_MMA(1, 0, At, B0); PG8_BAR; PG8_SCHED;
            PG8_STAGE(PG8_SB(0, 1), b2 + hstep, voffB);
            PG8_WAIT_V(6); PG8_BAR; PG8_MMA(1, 1, At, B1); PG8_BAR;
            PG8_LDB(B0, 1, 0); PG8_SCHED; PG8_LDA(At, 1, 0); PG8_STAGE(PG8_SA(0, 1), a2 + hstep, voffA);
            PG8_WAIT_L(8); PG8_BAR; PG8_WAIT_L(0); PG8_MMA(0, 0, At, B0); PG8_BAR; PG8_SCHED;
            PG8_LDB(B1, 1, 1); PG8_STAGE(PG8_SB(1, 0), b3, voffB);
            PG8_BAR; PG8_WAIT_L(0); PG8_MMA(0, 1, At, B1); PG8_BAR;
            PG8_LDA(At, 1, 1); PG8_STAGE(PG8_SA(1, 0), a3, voffA);
            PG8_BAR; PG8_WAIT_L(0); PG8_MMA(1, 0, At, B0); PG8_BAR; PG8_SCHED;
            PG8_STAGE(PG8_SB(1, 1), b3 + hstep, voffB);
            PG8_WAIT_V(6); PG8_BAR; PG8_MMA(1, 1, At, B1); PG8_BAR;
            }
        }
        if constexpr (ALIGN_EPI) { if (wr == 0) PG8_BAR; }
        if constexpr (!Epi::AFTER_DRAIN) { E(acc, cur, wr, wc, fr, fq); S.done(cur); }
        if (!has_next) break;
#pragma unroll
        for (int a = 0; a < 2; ++a)
#pragma unroll
            for (int b = 0; b < 2; ++b)
#pragma unroll
                for (int m = 0; m < 4; ++m)
#pragma unroll
                    for (int n = 0; n < 2; ++n) acc[a][b][m][n] = (f32x4){0.f, 0.f, 0.f, 0.f};
        cur = nxt; cA = nA; cB = nB; ++ui;
        if constexpr (ALIGN_EPI) { if (wr == 1) PG8_BAR; }
    }
    PG8_WAIT_V(0);
    if constexpr (!ALIGN_EPI) { if (wr == 0) PG8_BAR; }
    PG8_BAR;
    if constexpr (Epi::AFTER_DRAIN) { E.fused(acc, cur, wr, wc, fr, fq, lds, wid, lane); S.done(cur); }
#undef PG8_SA
#undef PG8_SB
#undef PG8_STAGE
#undef PG8_LDA
#undef PG8_LDB
#undef PG8_MMA
#undef PG8_WAIT_V
#undef PG8_WAIT_L
#undef PG8_BAR
#undef PG8_SCHED
}
}

constexpr int D = 1024, NB = 8, SEQ = 2048, NS = 16, SSEQ = 64, MP = NB * SEQ, M = MP + NS * SSEQ;
constexpr int DA = 512, DB = 512, DIN = 2048, FF = 3072, FF2 = 6144;
constexpr float EPS = 1e-6f;
constexpr size_t O_Y = 0, O_HP = (size_t)M * D, O_CP = O_HP + NB * DA, O_FP = O_CP + NB * 3 * DA, O_HS = O_FP + NB * 2 * FF2, O_CS = O_HS + NS * DA, O_FS = O_CS + NS * 3 * DA, O_VS = O_FS + NS * 2 * FF2,
                 O_END = O_VS + (size_t)NS * SSEQ * DB;
constexpr size_t MiB = 1u << 20;
constexpr size_t WS_CTL = 0, CTL_ZERO_BYTES = 65536;
constexpr size_t WS_WIN = 2 * MiB, WS_WO = 6 * MiB, WS_WUP = 8 * MiB, WS_WDN = 20 * MiB, WS_XN = 26 * MiB, WS_Z = 60 * MiB, WS_MIX = 128 * MiB, WS_HB = 60 * MiB, WS_F = 162 * MiB,
                 WS_XNB = 230 * MiB, WS_UB = 231 * MiB, WS_AGG = 237 * MiB, WS_WRF = 238 * MiB, WS_END = 239 * MiB;
constexpr int LDS_BYTES = 147456;

#define GAS __attribute__((address_space(1)))
#define LAS __attribute__((address_space(3)))
typedef unsigned short bf16;
typedef float f32x4 __attribute__((ext_vector_type(4)));
typedef short bf16x8 __attribute__((ext_vector_type(8)));
typedef unsigned v4u __attribute__((ext_vector_type(4)));
typedef unsigned v2u __attribute__((ext_vector_type(2)));
#define LDS_WAIT() asm volatile("s_waitcnt lgkmcnt(0)" ::: "memory")

__device__ __forceinline__ unsigned f2bf(float f) { unsigned u = __builtin_bit_cast(unsigned, f); return (u + 0x7fffu + ((u >> 16) & 1u)) >> 16; }
__device__ __forceinline__ unsigned pk2(float lo, float hi) { return f2bf(lo) | (f2bf(hi) << 16); }
__device__ __forceinline__ float bf2f(bf16 b) { return __builtin_bit_cast(float, (unsigned)b << 16); }
__device__ __forceinline__ float wave_sum(float v) {
#pragma unroll
    for (int o = 1; o < 64; o <<= 1) v += __shfl_xor(v, o);
    return v;
}
__device__ __forceinline__ float sigmoidf_(float z) { return __builtin_amdgcn_rcpf(1.0f + __builtin_amdgcn_exp2f(-1.4426950408889634f * z)); }

__device__ __forceinline__ void p0_transpose_item(const float* W, int K, int N, bf16* WT, bool up_perm, LAS float* scr, int item, int lane) {
    const int nblk = N / 32, kb = item / nblk, nb = item % nblk, k0 = 64 * kb, n0 = 32 * nb;
#pragma unroll 8
    for (int i = 0; i < 32; ++i) { const int kk = 2 * i + (lane >> 5); scr[kk * 33 + (lane & 31)] = W[(size_t)(k0 + kk) * N + n0 + (lane & 31)]; }
    LDS_WAIT(); asm volatile("" ::: "memory");
    int rb = n0; if (up_perm) { const int hi = n0 >= FF ? 1 : 0, cc = n0 - hi * FF; rb = (cc >> 7) * 256 + hi * 128 + (cc & 127); }
    const int c = lane & 7;
#pragma unroll
    for (int j = 0; j < 4; ++j) { const int n = (lane >> 3) + 8 * j; const LAS float* s = scr + (8 * c) * 33 + n;
        v4u o; o.x = pk2(s[0 * 33], s[1 * 33]); o.y = pk2(s[2 * 33], s[3 * 33]); o.z = pk2(s[4 * 33], s[5 * 33]); o.w = pk2(s[6 * 33], s[7 * 33]);
        *(v4u*)(WT + (size_t)(rb + n) * K + k0 + 8 * c) = o; }
    LDS_WAIT(); asm volatile("" ::: "memory");
}

struct P {
    const float *xp, *xs, *st_h, *st_conv, *st_ffn, *g_pre1, *w_in, *w_conv_a, *b_conv_a, *w_r, *b_r, *w_i, *b_i, *lam, *g_out_a, *g_v, *b_v, *w_s, *b_s, *g_out_b, *w_o, *g_post1, *g_pre2, *w_up,
                *w_conv_f, *b_conv_f, *w_down, *g_post2;
    float* out; unsigned char* ws;
};
__device__ __forceinline__ const float* xrow(const P& p, int m) { return m < MP ? p.xp + (size_t)m * D : p.xs + (size_t)(m - MP) * D; }

__device__ __forceinline__ void row_pre1(const P& p, int m, int lane) {
    const f32x4* xr = (const f32x4*)xrow(p, m) + lane; const f32x4* gr = (const f32x4*)p.g_pre1 + lane;
    f32x4 v[4]; float s = 0.f;
#pragma unroll
    for (int j = 0; j < 4; ++j) { v[j] = xr[64 * j]; s += (v[j].x * v[j].x + v[j].y * v[j].y) + (v[j].z * v[j].z + v[j].w * v[j].w); }
    const float rs = 1.0f / sqrtf(wave_sum(s) * (1.f / D) + EPS);
    unsigned long long* o8 = (unsigned long long*)((bf16*)(p.ws + WS_XN) + (size_t)m * D) + lane;
#pragma unroll
    for (int j = 0; j < 4; ++j) { const f32x4 g = gr[64 * j]; o8[64 * j] = (unsigned long long)pk2(v[j].x * rs * g.x, v[j].y * rs * g.y) | ((unsigned long long)pk2(v[j].z * rs * g.z, v[j].w * rs * g.w) << 32); }
}
__device__ __forceinline__ void row_post1(const P& p, int m, int lane) {
    const f32x4* xr = (const f32x4*)xrow(p, m) + lane; f32x4* yr = (f32x4*)(p.out + O_Y + (size_t)m * D) + lane;
    const f32x4* g1 = (const f32x4*)p.g_post1 + lane; const f32x4* g2 = (const f32x4*)p.g_pre2 + lane;
    f32x4 y[4]; float s = 0.f;
#pragma unroll
    for (int j = 0; j < 4; ++j) { y[j] = yr[64 * j]; s += (y[j].x * y[j].x + y[j].y * y[j].y) + (y[j].z * y[j].z + y[j].w * y[j].w); }
    const float rs = 1.0f / sqrtf(wave_sum(s) * (1.f / D) + EPS); float s2 = 0.f;
#pragma unroll
    for (int j = 0; j < 4; ++j) { y[j] = xr[64 * j] + y[j] * rs * g1[64 * j]; yr[64 * j] = y[j]; s2 += (y[j].x * y[j].x + y[j].y * y[j].y) + (y[j].z * y[j].z + y[j].w * y[j].w); }
    const float rs2 = 1.0f / sqrtf(wave_sum(s2) * (1.f / D) + EPS);
    unsigned long long* o8 = (unsigned long long*)((bf16*)(p.ws + WS_XN) + (size_t)m * D) + lane;
    unsigned long long* b8 = nullptr;
    if (m < MP - 64 && (m & 63) >= 62) b8 = (unsigned long long*)((bf16*)(p.ws + WS_XNB) + (size_t)(2 * ((m >> 6) + 1) + (m & 63) - 62) * D) + lane;
#pragma unroll
    for (int j = 0; j < 4; ++j) { const f32x4 g = g2[64 * j]; const unsigned long long w = (unsigned long long)pk2(y[j].x * rs2 * g.x, y[j].y * rs2 * g.y) | ((unsigned long long)pk2(y[j].z * rs2 * g.z, y[j].w * rs2 * g.w) << 32);
        o8[64 * j] = w; if (b8) b8[64 * j] = w; }
}
__device__ __forceinline__ void row_post2(const P& p, int m, int lane) {
    const f32x4* fr = (const f32x4*)((const float*)(p.ws + WS_F) + (size_t)m * D) + lane; f32x4* yr = (f32x4*)(p.out + O_Y + (size_t)m * D) + lane;
    const f32x4* g1 = (const f32x4*)p.g_post2 + lane;
    f32x4 y[4]; float s = 0.f;
#pragma unroll
    for (int j = 0; j < 4; ++j) { y[j] = fr[64 * j]; s += (y[j].x * y[j].x + y[j].y * y[j].y) + (y[j].z * y[j].z + y[j].w * y[j].w); }
    const float rs = 1.0f / sqrtf(wave_sum(s) * (1.f / D) + EPS);
#pragma unroll
    for (int j = 0; j < 4; ++j) yr[64 * j] = yr[64 * j] + y[j] * rs * g1[64 * j];
}

constexpr int MA_WL = 10752, MA_YS = 8 * MA_WL;
template <bool FINAL>
__device__ __forceinline__ void mixer_a_item(const P& p, LAS unsigned char* lds, int q, int wave, int lane) {
    const bool smp = q >= 256; const int b = q >> 5, cc = q & 31, sidx = q - 256;
    const int row0 = smp ? MP + sidx * SSEQ : b * SEQ + cc * 64;
    const int c = wave * 64 + lane;
    const bf16* Z = (const bf16*)(p.ws + WS_Z);
    float* AGG = (float*)(p.ws + WS_AGG);
    LAS unsigned char* wl = lds + wave * MA_WL;
    LAS bf16* XC = (LAS bf16*)wl;
    LAS float* RB = (LAS float*)(wl + 2560);
    LAS float* IB = (LAS float*)(wl + 2560 + 4096);
    LAS float* YS = (LAS float*)(lds + MA_YS);
    bf16x8 BR[2][4], BI[2][4];
    { const bf16x8* wf = (const bf16x8*)(p.ws + WS_WRF) + (size_t)wave * 8 * 64 + lane;
#pragma unroll
      for (int ks = 0; ks < 2; ++ks)
#pragma unroll
        for (int nt = 0; nt < 4; ++nt) { BR[ks][nt] = wf[(ks * 4 + nt) * 64]; BI[ks][nt] = wf[(size_t)8 * 8 * 64 + (ks * 4 + nt) * 64]; } }
    const float cw0 = p.w_conv_a[c], cw1 = p.w_conv_a[DA + c], cw2 = p.w_conv_a[2 * DA + c], cw3 = p.w_conv_a[3 * DA + c], cb = p.b_conv_a[c];
    const float br = p.b_r[c], bi = p.b_i[c];
    const float m8sp = -8.0f * log1pf(expf(-p.lam[c]));
    float xm3, xm2, xm1, h;
    if (smp) { const float* sc = p.st_conv + (size_t)sidx * 3 * DA; xm3 = sc[c]; xm2 = sc[DA + c]; xm1 = sc[2 * DA + c]; h = FINAL ? p.st_h[(size_t)sidx * DA + c] : 0.f; }
    else if (cc == 0) { xm3 = xm2 = xm1 = 0.f; h = 0.f; }
    else { const bf16* zp = Z + (size_t)(row0 - 3) * DIN + DA + c; xm3 = bf2f(zp[0]); xm2 = bf2f(zp[DIN]); xm1 = bf2f(zp[2 * DIN]); h = 0.f;
        if (FINAL) { const float* ag = AGG + (size_t)(b * 32) * 2 * DA + c; for (int k = 0; k < cc; ++k) h = ag[(size_t)k * 2 * DA] * h + ag[(size_t)k * 2 * DA + DA]; } }
    const bool first = !smp && cc == 0;
    float slog = 0.f;
    bf16* MIX = (bf16*)(p.ws + WS_MIX);
    const f32x4 ga = *(const f32x4*)(p.g_out_a + lane * 8), gb = *(const f32x4*)(p.g_out_a + lane * 8 + 4);
#pragma unroll 1
    for (int sc = 0; sc < 4; ++sc) {
        float xc[16];
        const bf16* zr = Z + (size_t)(row0 + sc * 16) * DIN + c;
#pragma unroll
        for (int tt = 0; tt < 16; ++tt) { const float xin = bf2f(zr[(size_t)tt * DIN + DA]);
            const float v = cb + cw0 * xm3 + cw1 * xm2 + cw2 * xm1 + cw3 * xin; xm3 = xm2; xm2 = xm1; xm1 = xin; xc[tt] = v; XC[tt * 72 + lane] = (bf16)f2bf(v); }
        LDS_WAIT();
        const bf16x8 a0 = *(const LAS bf16x8*)(XC + (lane & 15) * 72 + (lane >> 4) * 8), a1 = *(const LAS bf16x8*)(XC + (lane & 15) * 72 + 32 + (lane >> 4) * 8);
#pragma unroll
        for (int nt = 0; nt < 4; ++nt) { pg8::f32x4 ar = {0.f, 0.f, 0.f, 0.f}, ai = {0.f, 0.f, 0.f, 0.f};
            ar = __builtin_amdgcn_mfma_f32_16x16x32_bf16(a0, BR[0][nt], ar, 0, 0, 0); ar = __builtin_amdgcn_mfma_f32_16x16x32_bf16(a1, BR[1][nt], ar, 0, 0, 0);
            ai = __builtin_amdgcn_mfma_f32_16x16x32_bf16(a0, BI[0][nt], ai, 0, 0, 0); ai = __builtin_amdgcn_mfma_f32_16x16x32_bf16(a1, BI[1][nt], ai, 0, 0, 0);
#pragma unroll
            for (int r = 0; r < 4; ++r) { RB[((lane >> 4) * 4 + r) * 64 + nt * 16 + (lane & 15)] = ar[r]; IB[((lane >> 4) * 4 + r) * 64 + nt * 16 + (lane & 15)] = ai[r]; } }
        LDS_WAIT();
        if (FINAL && sc > 0) __syncthreads();
#pragma unroll
        for (int tt = 0; tt < 16; ++tt) {
            const float rg = sigmoidf_(RB[tt * 64 + lane] + br), ig = sigmoidf_(IB[tt * 64 + lane] + bi);
            const float la = m8sp * rg; const float a = __builtin_amdgcn_exp2f(1.4426950408889634f * la);
            float mult = sqrtf(-expm1f(2.0f * la)); if (first && sc == 0 && tt == 0) mult = 1.0f;
            h = a * h + mult * (ig * xc[tt]); slog += la;
            if (FINAL) { const float g = bf2f(zr[(size_t)tt * DIN]); YS[tt * DA + c] = h * pg8::gelu_tanh(g); }
        }
        LDS_WAIT();
        if (FINAL) {
            __syncthreads();
#pragma unroll
            for (int tj = 0; tj < 2; ++tj) { const int t = wave * 2 + tj;
                const f32x4 va = *(const LAS f32x4*)(YS + t * DA + lane * 8), vb = *(const LAS f32x4*)(YS + t * DA + lane * 8 + 4);
                const float ss = wave_sum((va.x * va.x + va.y * va.y) + (va.z * va.z + va.w * va.w) + (vb.x * vb.x + vb.y * vb.y) + (vb.z * vb.z + vb.w * vb.w));
                const float rs = 1.0f / sqrtf(ss * (1.f / DA) + EPS);
                v4u o; o.x = pk2(va.x * rs * ga.x, va.y * rs * ga.y); o.y = pk2(va.z * rs * ga.z, va.w * rs * ga.w); o.z = pk2(vb.x * rs * gb.x, vb.y * rs * gb.y); o.w = pk2(vb.z * rs * gb.z, vb.w * rs * gb.w);
                *(v4u*)(MIX + (size_t)(row0 + sc * 16 + t) * D + lane * 8) = o; }
            LDS_WAIT();
        }
    }
    if (!FINAL) { AGG[(size_t)q * 2 * DA + c] = expf(slog); AGG[(size_t)q * 2 * DA + DA + c] = h; return; }
    if (smp || cc == 31) {
        float* oh = smp ? p.out + O_HS + (size_t)sidx * DA : p.out + O_HP + (size_t)b * DA; oh[c] = h;
        float* oc = smp ? p.out + O_CS + (size_t)sidx * 3 * DA : p.out + O_CP + (size_t)b * 3 * DA; oc[c] = xm3; oc[DA + c] = xm2; oc[2 * DA + c] = xm1;
    }
    __syncthreads();
}

constexpr int VP = 132;
__device__ __forceinline__ void mixer_b_item(const P& p, LAS unsigned char* lds, int k, int wave, int lane) {
    const bool smp = k >= 128; const int sidx = k - 128; const int L = smp ? 64 : 128; const int row0 = smp ? MP + sidx * SSEQ : k * 128;
    const bf16* Z = (const bf16*)(p.ws + WS_Z);
    LAS bf16* VNt = (LAS bf16*)lds;
    const int RW = L / 8;
    {
    float gv[8], bv[8];
#pragma unroll
    for (int e = 0; e < 8; ++e) { gv[e] = p.g_v[e * 64 + lane]; bv[e] = p.b_v[e * 64 + lane]; }
#pragma unroll 1
    for (int jj = 0; jj < RW; ++jj) { const int j = wave * RW + jj; const bf16* zr = Z + (size_t)(row0 + j) * DIN + 3 * DA;
        float v[8]; float s = 0.f;
#pragma unroll
        for (int e = 0; e < 8; ++e) { v[e] = bf2f(zr[e * 64 + lane]); s += v[e]; }
        const float mu = wave_sum(s) * (1.f / DB); float s2 = 0.f;
#pragma unroll
        for (int e = 0; e < 8; ++e) { v[e] -= mu; s2 += v[e] * v[e]; }
        const float rstd = 1.0f / sqrtf(wave_sum(s2) * (1.f / DB) + EPS);
#pragma unroll
        for (int e = 0; e < 8; ++e) { const float vn = v[e] * rstd * gv[e] + bv[e]; VNt[(e * 64 + lane) * VP + j] = (bf16)f2bf(vn);
            if (smp) p.out[O_VS + ((size_t)sidx * SSEQ + j) * DB + e * 64 + lane] = vn; }
    }
    }
    __syncthreads();
    if (wave * 16 < L) {
        const int i0 = wave * 16, nks = (smp || i0 < 64) ? 2 : 4;
        const int il = lane & 15, kg = lane >> 4; const int row = row0 + i0 + il;
        bf16* MIX = (bf16*)(p.ws + WS_MIX);
        float ss = 0.f, rs = 0.f;
#pragma unroll 1
        for (int pass = 0; pass < 2; ++pass) {
#pragma unroll 1
            for (int hh = 0; hh < 4; ++hh) {
                bf16x8 wf[4];
#pragma unroll
                for (int ks = 0; ks < 4; ++ks) { wf[ks] = (bf16x8){0, 0, 0, 0, 0, 0, 0, 0};
                    if (ks < nks) { const float* wp = p.w_s + ((size_t)hh * 128 + i0 + il) * 128 + ks * 32 + kg * 8; const f32x4 w0 = *(const f32x4*)wp, w1 = *(const f32x4*)(wp + 4);
                        wf[ks][0] = (short)f2bf(w0.x); wf[ks][1] = (short)f2bf(w0.y); wf[ks][2] = (short)f2bf(w0.z); wf[ks][3] = (short)f2bf(w0.w);
                        wf[ks][4] = (short)f2bf(w1.x); wf[ks][5] = (short)f2bf(w1.y); wf[ks][6] = (short)f2bf(w1.z); wf[ks][7] = (short)f2bf(w1.w); } }
                const float bs = p.b_s[hh * 128 + i0 + il];
#pragma unroll 2
                for (int dt = 0; dt < 8; ++dt) { pg8::f32x4 a = {0.f, 0.f, 0.f, 0.f};
#pragma unroll
                    for (int ks = 0; ks < 4; ++ks) if (ks < nks) { const LAS bf16* vp = VNt + (hh * 128 + dt * 16 + il) * VP + ks * 32 + kg * 8;
                        typedef short s16x4 __attribute__((ext_vector_type(4)));
                        const s16x4 lo = *(const LAS s16x4*)vp, hi = *(const LAS s16x4*)(vp + 4);
                        const bf16x8 af = {lo[0], lo[1], lo[2], lo[3], hi[0], hi[1], hi[2], hi[3]};
                        a = __builtin_amdgcn_mfma_f32_16x16x32_bf16(af, wf[ks], a, 0, 0, 0); }
                    const int d0 = hh * 128 + dt * 16 + kg * 4; const pg8::f32x4 u4 = pg8::bf4_to_f4(Z + (size_t)row * DIN + 2 * DA + d0);
                    const pg8::f32x4 yv = u4 * (a + bs);
                    if (pass == 0) ss += (yv[0] * yv[0] + yv[1] * yv[1]) + (yv[2] * yv[2] + yv[3] * yv[3]);
                    else { const f32x4 g = *(const f32x4*)(p.g_out_b + d0);
                        v2u o; o.x = pk2(yv[0] * rs * g.x, yv[1] * rs * g.y); o.y = pk2(yv[2] * rs * g.z, yv[3] * rs * g.w);
                        *(v2u*)(MIX + (size_t)row * D + DA + d0) = o; }
                }
            }
            if (pass == 0) { ss += __shfl_xor(ss, 16); ss += __shfl_xor(ss, 32); rs = 1.0f / sqrtf(ss * (1.f / DB) + EPS); }
        }
    }
    __syncthreads();
}


#define XB_TMO      128
#define XB_XCNT(j)  (256  + 64 * (j))
#define XB_XSUB(j)  (1280 + 64 * (j))
#define XB_XGEN(j)  (2304 + 64 * (j))
#define XB_TOP      3328
#define XB_TOPGEN   3392
#define XCD_BAR_WORDS 3456
#define XB_SPIN_CAP (1u << 18)

__device__ __forceinline__ unsigned xb_ld(unsigned* p)              { return __hip_atomic_load(p, __ATOMIC_RELAXED, __HIP_MEMORY_SCOPE_AGENT); }
__device__ __forceinline__ unsigned xb_add(unsigned* p, unsigned v) { return __hip_atomic_fetch_add(p, v, __ATOMIC_RELAXED, __HIP_MEMORY_SCOPE_AGENT); }
__device__ __forceinline__ unsigned xb_xcc_id() { return (unsigned)__builtin_amdgcn_s_getreg((3 << 11) | 20) & 0xFu; }
#define XB_SPIN(cond, bar) do { unsigned _sp = 0; while (cond) { __builtin_amdgcn_s_sleep(1); \
    if ((++_sp & 255u) == 0u) { if (xb_ld(&(bar)[XB_TMO])) break; if (_sp > XB_SPIN_CAP) { atomicAdd(&(bar)[XB_TMO], 1u); break; } } } } while (0)

struct XcdBarrier {
    unsigned* bar; unsigned x;
    volatile LAS unsigned* st;
};

__device__ __forceinline__ XcdBarrier xcd_barrier_post(unsigned* bar, volatile LAS unsigned* st) {
    XcdBarrier b; b.bar = bar; b.x = xb_xcc_id(); b.st = st;
    if (threadIdx.x == 0) (void)xb_add(&bar[XB_XCNT(b.x)], 1u);
    return b;
}
__device__ __forceinline__ void xcd_barrier_complete(unsigned* bar, unsigned x, unsigned& nloc, unsigned& nx) {
    const unsigned G = gridDim.x * gridDim.y * gridDim.z;
    unsigned sum, cnt, mine, sp = 0u;
    for (;;) {
        sum = 0u; cnt = 0u; mine = 0u;
#pragma unroll
        for (unsigned j = 0; j < 16; ++j) { const unsigned c = xb_ld(&bar[XB_XCNT(j)]); sum += c; cnt += (c > 0u) ? 1u : 0u; mine = (j == x) ? c : mine; }
        if (sum == G) break;
        __builtin_amdgcn_s_sleep(1);
        if ((++sp & 255u) == 0u) { if (xb_ld(&bar[XB_TMO])) break; if (sp > XB_SPIN_CAP) { atomicAdd(&bar[XB_TMO], 1u); break; } }
    }
    nloc = mine > 0u ? mine : 1u; nx = cnt > 0u ? cnt : 1u;
}

__device__ __forceinline__ void xcd_barrier(const XcdBarrier& b) {
    asm volatile("s_waitcnt vmcnt(0)" ::: "memory");
    __syncthreads();
    if (threadIdx.x == 0) {
        unsigned* bar = b.bar;
        __builtin_amdgcn_s_waitcnt(0);
        unsigned nloc = b.st[0], nx = b.st[1];
        if (nloc == 0u) { xcd_barrier_complete(bar, b.x, nloc, nx); b.st[0] = nloc; b.st[1] = nx; }
        const unsigned old = xb_add(&bar[XB_XSUB(b.x)], 1u);
        const unsigned gen = old / nloc;
        if (old + 1u == (gen + 1u) * nloc) {
            __builtin_amdgcn_fence(__ATOMIC_RELEASE, "agent");
            asm volatile("s_waitcnt vmcnt(0)" ::: "memory");
            const unsigned og = xb_add(&bar[XB_TOP], 1u);
            const unsigned tg = og / nx;
            if (og + 1u == (tg + 1u) * nx) xb_add(&bar[XB_TOPGEN], 1u);
            else XB_SPIN(xb_ld(&bar[XB_TOPGEN]) == tg, bar);
            __builtin_amdgcn_fence(__ATOMIC_ACQUIRE, "agent");
            xb_add(&bar[XB_XGEN(b.x)], 1u);
            asm volatile("s_waitcnt vmcnt(0)" ::: "memory");
        } else {
            XB_SPIN(xb_ld(&bar[XB_XGEN(b.x)]) == gen, bar);
            __builtin_amdgcn_fence(__ATOMIC_ACQUIRE, "agent");
            asm volatile("s_waitcnt vmcnt(0)" ::: "memory");
        }
    }
    __syncthreads();
}

struct Args { const float* in[28]; float* out; unsigned char* ws; int ph_lo, ph_hi; };
constexpr int NPH = 10;
__global__ void __launch_bounds__(512, 2) fwd(Args args) {
    extern __shared__ __attribute__((aligned(16))) unsigned char lds_raw[];
    LAS unsigned char* lds = (LAS unsigned char*)lds_raw;
    const int tid = threadIdx.x, lane = tid & 63, wave = __builtin_amdgcn_readfirstlane(tid >> 6);
    const int G = gridDim.x, bx = blockIdx.x;
    const int gw = bx * 8 + wave, NGW = G * 8;
    P p;
    p.xp = args.in[0]; p.xs = args.in[1]; p.st_h = args.in[2]; p.st_conv = args.in[3]; p.st_ffn = args.in[4]; p.g_pre1 = args.in[5]; p.w_in = args.in[6]; p.w_conv_a = args.in[7]; p.b_conv_a = args.in[8];
    p.w_r = args.in[9]; p.b_r = args.in[10]; p.w_i = args.in[11]; p.b_i = args.in[12]; p.lam = args.in[13]; p.g_out_a = args.in[14]; p.g_v = args.in[15]; p.b_v = args.in[16]; p.w_s = args.in[17]; p.b_s = args.in[18];
    p.g_out_b = args.in[19]; p.w_o = args.in[20]; p.g_post1 = args.in[21]; p.g_pre2 = args.in[22]; p.w_up = args.in[23]; p.w_conv_f = args.in[24]; p.b_conv_f = args.in[25]; p.w_down = args.in[26]; p.g_post2 = args.in[27];
    p.out = args.out; p.ws = args.ws;
    unsigned char* ws = args.ws;
    bf16 *Wt_in = (bf16*)(ws + WS_WIN), *Wt_o = (bf16*)(ws + WS_WO), *Wt_up = (bf16*)(ws + WS_WUP), *Wt_dn = (bf16*)(ws + WS_WDN);
    bf16 *XN = (bf16*)(ws + WS_XN), *Zb = (bf16*)(ws + WS_Z), *MIX = (bf16*)(ws + WS_MIX), *HB = (bf16*)(ws + WS_HB), *XNB = (bf16*)(ws + WS_XNB), *UB = (bf16*)(ws + WS_UB);
    float* Fb = (float*)(ws + WS_F);
    const int lo = args.ph_lo, hi = args.ph_hi;
    volatile LAS unsigned* MISC = (volatile LAS unsigned*)(lds + LDS_BYTES - 64);
    if (tid < 16) MISC[tid] = 0u;
    __syncthreads();
    XcdBarrier bar = xcd_barrier_post((unsigned*)(ws + WS_CTL) + 1024, MISC);
#ifndef PHASE_MASK
#define PHASE_MASK 0x3ff
#endif
#define IN(k) ((((PHASE_MASK) >> (k)) & 1) && lo <= (k) && (k) < hi)
#ifndef SYNC_REPS
#define SYNC_REPS 1
#endif
#ifndef MIX_REPS
#define MIX_REPS 1
#endif
#define SEAM(k) do { if (IN(k) && IN((k) + 1)) { for (int r_ = 0; r_ < SYNC_REPS; ++r_) xcd_barrier(bar); } } while (0)

    if (IN(0)) {
        LAS float* scr = (LAS float*)(lds + wave * 16384);
        constexpr int I_IN = (D / 64) * (DIN / 32), I_O = (D / 64) * (D / 32), I_UP = (D / 64) * (FF2 / 32), I_DN = (FF / 64) * (D / 32);
        for (int it = gw; it < I_IN + I_O + I_UP + I_DN; it += NGW) { int r = it;
            if (r < I_IN) { p0_transpose_item(p.w_in, D, DIN, Wt_in, false, scr, r, lane); continue; } r -= I_IN;
            if (r < I_O) { p0_transpose_item(p.w_o, D, D, Wt_o, false, scr, r, lane); continue; } r -= I_O;
            if (r < I_UP) { p0_transpose_item(p.w_up, D, FF2, Wt_up, true, scr, r, lane); continue; } r -= I_UP;
            p0_transpose_item(p.w_down, FF, D, Wt_dn, false, scr, r, lane); }
        for (int idx = bx * 512 + tid; idx < 2 * 8 * 8 * 64 * 8; idx += G * 512) { const int j = idx & 7, ln = (idx >> 3) & 63, f = (idx >> 9) & 7, hh = (idx >> 12) & 7, mat = idx >> 15;
            const int d = (f >> 2) * 32 + (ln >> 4) * 8 + j, e = (f & 3) * 16 + (ln & 15);
            ((bf16*)(ws + WS_WRF))[idx] = (bf16)f2bf((mat ? p.w_i : p.w_r)[(size_t)hh * 4096 + d * 64 + e]); }
        for (int m = gw; m < M; m += NGW) row_pre1(p, m, lane);
        __syncthreads();
    }
    SEAM(0);
    if (IN(1)) { pg8::Gemm g{XN, Wt_in, M, DIN, D}; pg8::StaticOrder S; S.init(M, DIN, G, bx);
        pg8::EpiBf16<0> E{Zb, DIN, nullptr, 0, 0, 1.f};
        pg8::gemm_phase<pg8::EpiBf16<0>, pg8::StaticOrder, true, true>(lds, g, S, E); }
    SEAM(1);
    for (int rep_ = 0; rep_ < MIX_REPS; ++rep_) {
    if (IN(2)) { for (int it = bx; it < NB * 31; it += G) { const int q = (it / 31) * 32 + it % 31; mixer_a_item<false>(p, lds, q, wave, lane); } }
    SEAM(2);
    if (IN(3)) { for (int it = bx; it < 272 + 144; it += G) { if (it < 272) mixer_a_item<true>(p, lds, it, wave, lane); else mixer_b_item(p, lds, it - 272, wave, lane); } }
    SEAM(3);
    }
    if (IN(4)) { pg8::Gemm g{MIX, Wt_o, M, D, D}; pg8::StaticOrder S; S.init(M, D, G, bx);
        pg8::EpiF32 E{p.out + O_Y, D, nullptr};
        pg8::gemm_phase<pg8::EpiF32, pg8::StaticOrder, true, true>(lds, g, S, E); }
    SEAM(4);
    if (IN(5)) { for (int m = gw; m < M; m += NGW) row_post1(p, m, lane); }
    SEAM(5);
    if (IN(6)) { pg8::Gemm g{XNB, Wt_up, 512, FF2, D}; pg8::StaticOrder S; S.init(512, FF2, G, bx);
        pg8::EpiBf16<0> E{UB, FF2, nullptr, 0, 0, 1.f};
        pg8::gemm_phase<pg8::EpiBf16<0>, pg8::StaticOrder, true, true>(lds, g, S, E); }
    SEAM(6);
    if (IN(7)) { pg8::Gemm g{XN, Wt_up, M, FF2, D}; pg8::StaticOrder S; S.init(M, FF2, G, bx);
        pg8::EpiConvGeglu E{HB, UB, p.st_ffn, p.w_conv_f, p.b_conv_f, p.out + O_FP, p.out + O_FS};
        pg8::gemm_phase<pg8::EpiConvGeglu, pg8::StaticOrder, true, true>(lds, g, S, E); }
    SEAM(7);
    if (IN(8)) { pg8::Gemm g{HB, Wt_dn, M, D, FF}; pg8::StaticOrder S; S.init(M, D, G, bx);
        pg8::EpiF32 E{Fb, D, nullptr};
        pg8::gemm_phase<pg8::EpiF32, pg8::StaticOrder, true, true>(lds, g, S, E); }
    SEAM(8);
    if (IN(9)) { for (int m = gw; m < M; m += NGW) row_post2(p, m, lane); }
#undef IN
#undef SEAM
}

extern "C" void kernel_launch(void* const* d_in, const int* in_sizes, int n_in, void* d_out, int out_size, void* d_ws, size_t ws_size, hipStream_t stream) {
    static int grid = 0;
    if (grid == 0) {
        if (n_in != 28 || (size_t)out_size != O_END || ws_size < WS_END) { fprintf(stderr, "kernel_launch: unexpected shapes: n_in %d out %d ws %zu\n", n_in, out_size, ws_size); grid = -1; return; }
        int dev = 0, cus = 0, per_cu = 0;
        if (hipGetDevice(&dev) != hipSuccess || hipDeviceGetAttribute(&cus, hipDeviceAttributeMultiprocessorCount, dev) != hipSuccess) { grid = -1; return; }
        if (hipFuncSetAttribute((const void*)fwd, hipFuncAttributeMaxDynamicSharedMemorySize, LDS_BYTES) != hipSuccess) { fprintf(stderr, "kernel_launch: hipFuncSetAttribute failed\n"); grid = -1; return; }
        if (hipOccupancyMaxActiveBlocksPerMultiprocessor(&per_cu, (const void*)fwd, 512, LDS_BYTES) != hipSuccess || per_cu < 1) { fprintf(stderr, "kernel_launch: occupancy query failed (%d)\n", per_cu); (void)hipGetLastError(); per_cu = 1; }
        grid = cus * 1;
        if (grid > 256) grid = 256;
    }
    if (grid < 0) return;
    if (hipMemsetAsync((char*)d_ws + WS_CTL, 0, CTL_ZERO_BYTES, stream) != hipSuccess) { fprintf(stderr, "kernel_launch: memset failed\n"); return; }
    Args a{};
    for (int i = 0; i < 28; ++i) a.in[i] = (const float*)d_in[i];
    a.out = (float*)d_out; a.ws = (unsigned char*)d_ws; a.ph_lo = 0; a.ph_hi = NPH;
    void* kargs[] = {&a};
    const hipError_t e = hipLaunchCooperativeKernel((const void*)fwd, dim3(grid), dim3(512), kargs, LDS_BYTES, stream);
    if (e != hipSuccess) fprintf(stderr, "kernel_launch: cooperative launch failed: %s (grid %d)\n", hipGetErrorString(e), grid);
}
```

```cpp
#include <hip/hip_runtime.h>
#include <cstdio>
#include <cstdint>
namespace pg8 {
#define PG8_LAS __attribute__((address_space(3)))
typedef unsigned short bf16_t;
typedef short bf16x8 __attribute__((ext_vector_type(8)));
typedef float f32x4 __attribute__((ext_vector_type(4)));
typedef unsigned u32x4 __attribute__((ext_vector_type(4)));
constexpr int BM = 256, BK = 64, HALF = 128, HTB = HALF * BK * 2  , STAGE_BYTES = 8 * HTB, NXCD = 8, WGM = 8;

__host__ __device__ __forceinline__ int lds_byte(int r, int c) { const int st = (r >> 4) * 2 + (c >> 5), rr = r & 15, cc = c & 31, ob = rr * 64 + cc * 2; return st * 1024 + (ob ^ (((ob >> 9) & 1) << 5)); }
__host__ __device__ __forceinline__ void stage_rc(int b, int& R, int& C) { const int st = b / 1024, sb = b % 1024, swz = sb ^ (((sb >> 9) & 1) << 5); R = (st >> 1) * 16 + swz / 64; C = (st & 1) * 32 + (swz % 64) / 2; }
__host__ __device__ __forceinline__ int perm32(int rho) { const int n = rho >> 4, i = rho & 15; return 8 * (i >> 2) + 4 * n + (i & 3); }

struct Unit { int pm, pn, k0, ks; };
struct Gemm { const bf16_t* A; const bf16_t* Bt; int M, N, K, ld; };

struct StaticOrder {
    int nM, nN, nwg, G, c;
    __host__ __device__ void init(int M, int N, int G_, int c_) { nM = M / BM; nN = N / BM; nwg = nM * nN; G = G_; c = c_; }
    __host__ __device__ bool next(int i, Unit& u) const {
        const long L = (long)i * G + c; if (L >= nwg) return false;
        int wgid = (int)L; { const int q = nwg / NXCD, r = nwg % NXCD, xcd = wgid % NXCD, off = wgid / NXCD; wgid = (xcd < r ? xcd * (q + 1) : r * (q + 1) + (xcd - r) * q) + off; }
        const int nig = WGM * nN, gid = wgid / nig, fm = gid * WGM, gsz = (nM - fm) < WGM ? (nM - fm) : WGM;
        u.pm = fm + ((wgid % nig) % gsz); u.pn = (wgid % nig) / gsz; u.k0 = 0; u.ks = 0; return true;
    }
    __device__ __forceinline__ void a_ready(const Unit&) const {}
    __device__ __forceinline__ void done(const Unit&) const {}
};

struct SplitOrder {
    int pm0, nP, nN, nS, Kc, c;
    __host__ __device__ void init(int pm0_, int nP_, int nN_, int nS_, int Kc_, int c_) { pm0 = pm0_; nP = nP_; nN = nN_; nS = nS_; Kc = Kc_; c = c_; }
    __host__ __device__ bool next(int i, Unit& u) const {
        if (i > 0 || c >= nP * nN * nS) return false;
        u.ks = c % nS; u.pn = (c / nS) % nN; u.pm = pm0 + c / (nS * nN); u.k0 = u.ks * Kc; return true;
    }
    __device__ __forceinline__ void a_ready(const Unit&) const {}
    __device__ __forceinline__ void done(const Unit&) const {}
};
__device__ __forceinline__ unsigned cvt_pk_bf16(float lo, float hi) { unsigned r; asm volatile("v_cvt_pk_bf16_f32 %0, %1, %2" : "=v"(r) : "v"(lo), "v"(hi)); return r; }
typedef float f32x2 __attribute__((ext_vector_type(2)));
__device__ __forceinline__ f32x2 gelu_pk(f32x2 v) {
    const f32x2 av = __builtin_elementwise_abs(v), d = av * 0.2316418882f + 1.0f;
    f32x2 t; t.x = __builtin_amdgcn_rcpf(d.x); t.y = __builtin_amdgcn_rcpf(d.y);
    f32x2 q = t * 0.5307027145f + (-0.7265760135f); q = q * t + 0.7107068705f; q = q * t + (-0.142248368f); q = q * t + 0.127414796f; q = q * t;
    const f32x2 s = (v * v) * (-0.72134752044f);
    f32x2 e; e.x = __builtin_amdgcn_exp2f(s.x); e.y = __builtin_amdgcn_exp2f(s.y);
    const f32x2 m = v * (q * e), r = v - m;
    f32x2 o; o.x = v.x < 0.f ? m.x : r.x; o.y = v.y < 0.f ? m.y : r.y; return o;
}

template <int ACT  > struct EpiBf16 {
    static constexpr bool PERM = true, AFTER_DRAIN = false; static_assert(ACT == 0 || ACT == 1, "EpiBf16: ACT is 0 (none) or 1 (gelu_pk)");
    bf16_t* O; int ldc; const float* bias; int split_cols; size_t split_stride; float scale0;
    __device__ __forceinline__ void operator()(const f32x4 (&acc)[2][2][4][2], const Unit& u, int wr, int wc, int fr, int fq) const {
        const int row0 = u.pm * BM + wr * 64 + fr; int colt = u.pn * BM; bf16_t* base = O;
        float sc = 1.f; if (split_cols) { const int t = colt / split_cols; base += (size_t)t * split_stride; colt -= t * split_cols; if (t == 0) sc = scale0; }
        const int col0 = colt + wc * 32 + 8 * fq, bcol0 = u.pn * BM + wc * 32 + 8 * fq;
        f32x4 bv[2][2];
#pragma unroll
        for (int bj = 0; bj < 2; ++bj)
#pragma unroll
            for (int n = 0; n < 2; ++n) bv[bj][n] = bias ? *(const f32x4*)(bias + bcol0 + bj * HALF + 4 * n) : (f32x4){0.f, 0.f, 0.f, 0.f};
#pragma unroll
        for (int ai = 0; ai < 2; ++ai)
#pragma unroll
            for (int m = 0; m < 4; ++m) { bf16_t* rowp = base + (size_t)(row0 + ai * HALF + m * 16) * ldc + col0;
#pragma unroll
                for (int bj = 0; bj < 2; ++bj) { f32x4 v0 = acc[ai][bj][m][0] + bv[bj][0], v1 = acc[ai][bj][m][1] + bv[bj][1];
                    if (ACT == 1) { f32x2 a = gelu_pk((f32x2){v0[0], v0[1]}), b = gelu_pk((f32x2){v0[2], v0[3]}), c = gelu_pk((f32x2){v1[0], v1[1]}), d = gelu_pk((f32x2){v1[2], v1[3]});
                        v0 = (f32x4){a.x, a.y, b.x, b.y}; v1 = (f32x4){c.x, c.y, d.x, d.y}; }
                    v0 = v0 * sc; v1 = v1 * sc; u32x4 w; w.x = cvt_pk_bf16(v0[0], v0[1]); w.y = cvt_pk_bf16(v0[2], v0[3]); w.z = cvt_pk_bf16(v1[0], v1[1]); w.w = cvt_pk_bf16(v1[2], v1[3]);
                    *(u32x4*)(rowp + bj * HALF) = w; } }
    }
};
struct EpiF32 {
    static constexpr bool PERM = false, AFTER_DRAIN = false;
    float* C; int ldc; const float* bias; int pm0; size_t ks_stride;
    __device__ __forceinline__ void operator()(const f32x4 (&acc)[2][2][4][2], const Unit& u, int wr, int wc, int fr, int fq) const {
        const int row0 = (u.pm - pm0) * BM + wr * 64 + fr, col0 = u.pn * BM + wc * 32 + 4 * fq; float* C = this->C + (size_t)u.ks * ks_stride;
        f32x4 bv[2][2];
#pragma unroll
        for (int bj = 0; bj < 2; ++bj)
#pragma unroll
            for (int n = 0; n < 2; ++n) bv[bj][n] = bias ? *(const f32x4*)(bias + col0 + bj * HALF + n * 16) : (f32x4){0.f, 0.f, 0.f, 0.f};
#pragma unroll
        for (int ai = 0; ai < 2; ++ai)
#pragma unroll
            for (int m = 0; m < 4; ++m) { float* rowp = C + (size_t)(row0 + ai * HALF + m * 16) * ldc + col0;
#pragma unroll
                for (int bj = 0; bj < 2; ++bj)
#pragma unroll
                    for (int n = 0; n < 2; ++n) *(f32x4*)(rowp + bj * HALF + n * 16) = acc[ai][bj][m][n] + bv[bj][n]; }
    }
};
__device__ __forceinline__ float dpp_shr1(float old, float src) { return __builtin_bit_cast(float, __builtin_amdgcn_update_dpp(__builtin_bit_cast(int, old), __builtin_bit_cast(int, src), 0x111, 0xf, 0xf, false)); }
__device__ __forceinline__ float dpp_shr2(float old, float src) { return __builtin_bit_cast(float, __builtin_amdgcn_update_dpp(__builtin_bit_cast(int, old), __builtin_bit_cast(int, src), 0x112, 0xf, 0xf, false)); }
__device__ __forceinline__ float dpp_ror1(float src) { return __builtin_bit_cast(float, __builtin_amdgcn_update_dpp(0, __builtin_bit_cast(int, src), 0x121, 0xf, 0xf, false)); }
__device__ __forceinline__ float dpp_ror2(float src) { return __builtin_bit_cast(float, __builtin_amdgcn_update_dpp(0, __builtin_bit_cast(int, src), 0x122, 0xf, 0xf, false)); }
__device__ __forceinline__ float gelu_tanh(float x) {
    const float t = x * x, inner = x * (2.302208198f + 0.102943240f * t);
    return x * __builtin_amdgcn_rcpf(1.0f + __builtin_amdgcn_exp2f(-inner));
}
__device__ __forceinline__ f32x4 bf4_to_f4(const bf16_t* p) { const unsigned long long w = *(const unsigned long long*)p;
    return (f32x4){__builtin_bit_cast(float, (unsigned)(w << 16)), __builtin_bit_cast(float, (unsigned)w & 0xffff0000u), __builtin_bit_cast(float, (unsigned)(w >> 32) << 16), __builtin_bit_cast(float, (unsigned)(w >> 32) & 0xffff0000u)}; }

struct EpiConvGeglu {
    static constexpr bool PERM = true, AFTER_DRAIN = false;
    bf16_t* HB;
    const float* UB;
    const float* state;
    const float* wcv;
    const float* bcv;
    float* out_p;
    float* out_s;
    __device__ __forceinline__ void operator()(const f32x4 (&acc)[2][2][4][2], const Unit& u, int wr, int wc, int fr, int fq) const {
        const int cgb = u.pn * 128 + wc * 32 + 8 * fq;
        const int npb = u.pn * 256 + wc * 32 + 8 * fq;
#pragma unroll
        for (int n = 0; n < 2; ++n) {
            const int cg = cgb + 4 * n;
            const f32x4 w0g = *(const f32x4*)(wcv + cg), w1g = *(const f32x4*)(wcv + 6144 + cg), w2g = *(const f32x4*)(wcv + 12288 + cg), bg = *(const f32x4*)(bcv + cg);
            const f32x4 w0v = *(const f32x4*)(wcv + 3072 + cg), w1v = *(const f32x4*)(wcv + 6144 + 3072 + cg), w2v = *(const f32x4*)(wcv + 12288 + 3072 + cg), bv = *(const f32x4*)(bcv + 3072 + cg);
#pragma unroll
            for (int ai = 0; ai < 2; ++ai) {
                const int r0 = u.pm * BM + ai * HALF + wr * 64;
                f32x4 c1g, c2g, c1v, c2v;
                if (r0 >= 16384) { const float* st = state + (size_t)((r0 - 16384) >> 6) * 2 * 6144;
                    c2g = *(const f32x4*)(st + cg); c1g = *(const f32x4*)(st + 6144 + cg); c2v = *(const f32x4*)(st + 3072 + cg); c1v = *(const f32x4*)(st + 6144 + 3072 + cg); }
                else if ((r0 & 2047) == 0) { c1g = c2g = c1v = c2v = (f32x4){0.f, 0.f, 0.f, 0.f}; }
                else { const float* ub = UB + (size_t)(2 * (r0 >> 6)) * 6144 + npb + 4 * n; constexpr size_t PS = (size_t)512 * 6144;
#define UB4(off) ((*(const f32x4*)(ub + (off)) + *(const f32x4*)(ub + PS + (off))) + (*(const f32x4*)(ub + 2 * PS + (off)) + *(const f32x4*)(ub + 3 * PS + (off))))
                    c2g = UB4(0); c1g = UB4(6144); c2v = UB4(128); c1v = UB4(6144 + 128);
#undef UB4
                }
#pragma unroll
                for (int m = 0; m < 4; ++m) {
                    const f32x4 xg = acc[ai][0][m][n], xv = acc[ai][1][m][n];
                    f32x4 o1g, o2g, o1v, o2v;
                    if (m == 0) { o1g = c1g; o1v = c1v; o2g = (fr == 0) ? c2g : c1g; o2v = (fr == 0) ? c2v : c1v; }
                    else { const f32x4 pg = acc[ai][0][m > 0 ? m - 1 : 0][n], pv = acc[ai][1][m > 0 ? m - 1 : 0][n];
#pragma unroll
                        for (int e = 0; e < 4; ++e) { o1g[e] = dpp_ror1(pg[e]); o2g[e] = dpp_ror2(pg[e]); o1v[e] = dpp_ror1(pv[e]); o2v[e] = dpp_ror2(pv[e]); } }
                    float res[4];
#pragma unroll
                    for (int e = 0; e < 4; ++e) {
                        const float g1 = dpp_shr1(o1g[e], xg[e]), g2 = dpp_shr2(o2g[e], xg[e]);
                        const float v1 = dpp_shr1(o1v[e], xv[e]), v2 = dpp_shr2(o2v[e], xv[e]);
                        const float cgv = bg[e] + w0g[e] * g2 + w1g[e] * g1 + w2g[e] * xg[e];
                        const float cvv = bv[e] + w0v[e] * v2 + w1v[e] * v1 + w2v[e] * xv[e];
                        res[e] = gelu_tanh(cgv) * cvv;
                    }
                    typedef unsigned u32x2v __attribute__((ext_vector_type(2)));
                    u32x2v w; w.x = cvt_pk_bf16(res[0], res[1]); w.y = cvt_pk_bf16(res[2], res[3]);
                    *(u32x2v*)(HB + (size_t)(r0 + 16 * m + fr) * 3072 + cg) = w;
                }
                const bool smp = r0 >= 16384;
                if ((smp || (((r0 + 64) & 2047) == 0)) && fr >= 14) {
                    float* o = (smp ? out_s + (size_t)((r0 - 16384) >> 6) * 2 * 6144 : out_p + (size_t)(r0 >> 11) * 2 * 6144) + (fr - 14) * 6144;
                    *(f32x4*)(o + cg) = acc[ai][0][3][n]; *(f32x4*)(o + 3072 + cg) = acc[ai][1][3][n];
                }
            }
        }
    }
};
template <class Epi, class Sched, bool ALIGN_EPI = false, bool SP2 = false>
__device__ __forceinline__ void gemm_phase(PG8_LAS unsigned char* lds, const Gemm g, const Sched& S, const Epi& E) {
    const int tid = threadIdx.x, wid = __builtin_amdgcn_readfirstlane(tid >> 6), lane = tid & 63, wr = wid >> 2, wc = wid & 3, fr = lane & 15, fq = lane >> 4;
    const int K = g.ld, nt = g.K / BK;
    unsigned voffA[2], voffB[2];
#pragma unroll
    for (int i = 0; i < 2; ++i) { int R, C; stage_rc(tid * 16 + i * 8192, R, C); const int Rb = Epi::PERM ? ((R & ~31) + perm32(R & 31)) : R;
        voffA[i] = (unsigned)(R * K + C) * 2u; voffB[i] = (unsigned)(Rb * K + C) * 2u; }
    const size_t kstep = (size_t)(BK * 2);
    const size_t hstep = (size_t)HALF * K * 2;
    const size_t tstep = 2 * hstep;
    const unsigned ldsw = (unsigned)wid * 1024u;
    const int aoff = lds_byte(wr * 64 + fr, fq * 8), boff = lds_byte(wc * 32 + fr, fq * 8);
#define PG8_SA(b, h) (((b) * 2 + (h)) * HTB)
#define PG8_SB(b, h) ((4 + (b) * 2 + (h)) * HTB)
#define PG8_STAGE(bufoff, gbase, voff) do { _Pragma("unroll") for (int _i = 0; _i < 2; ++_i) \
        __builtin_amdgcn_global_load_lds((const unsigned*)((const char*)(gbase) + (voff)[_i]), (PG8_LAS unsigned*)(lds + (bufoff) + ldsw + _i * 8192), 16, 0, 0); } while (0)
#define PG8_LDA(dst, b, h) do { _Pragma("unroll") for (int m = 0; m < 4; ++m) _Pragma("unroll") for (int k = 0; k < 2; ++k) dst[m][k] = *(const PG8_LAS bf16x8*)(lds + PG8_SA(b, h) + aoff + m * 2048 + k * 1024); } while (0)
#define PG8_LDB(dst, b, h) do { _Pragma("unroll") for (int n = 0; n < 2; ++n) _Pragma("unroll") for (int k = 0; k < 2; ++k) dst[n][k] = *(const PG8_LAS bf16x8*)(lds + PG8_SB(b, h) + boff + n * 2048 + k * 1024); } while (0)
#define PG8_MMA(ai, bj, At, Bt) do { __builtin_amdgcn_s_setprio(1); _Pragma("unroll") for (int m = 0; m < 4; ++m) _Pragma("unroll") for (int n = 0; n < 2; ++n) _Pragma("unroll") for (int k = 0; k < 2; ++k) \
        acc[ai][bj][m][n] = __builtin_amdgcn_mfma_f32_16x16x32_bf16(Bt[n][k], At[m][k], acc[ai][bj][m][n], 0, 0, 0); __builtin_amdgcn_s_setprio(0); } while (0)
#define PG8_WAIT_V(n) asm volatile("s_waitcnt vmcnt(" #n ")" ::: "memory")
#define PG8_WAIT_L(n) asm volatile("s_waitcnt lgkmcnt(" #n ")" ::: "memory")
#define PG8_BAR __builtin_amdgcn_s_barrier()
#define PG8_SCHED __builtin_amdgcn_sched_barrier(0)
    Unit cur, nxt; int ui = 0;
    if (!S.next(0, cur)) return;
    f32x4 acc[2][2][4][2];
#pragma unroll
    for (int a = 0; a < 2; ++a)
#pragma unroll
        for (int b = 0; b < 2; ++b)
#pragma unroll
            for (int m = 0; m < 4; ++m)
#pragma unroll
                for (int n = 0; n < 2; ++n) acc[a][b][m][n] = (f32x4){0.f, 0.f, 0.f, 0.f};
    bf16x8 At[4][2], B0[2][2], B1[2][2];
    const char* cA = (const char*)g.A + (size_t)cur.pm * tstep + (size_t)cur.k0 * 2; const char* cB = (const char*)g.Bt + (size_t)cur.pn * tstep + (size_t)cur.k0 * 2;
    S.a_ready(cur);
    if constexpr (SP2) {
        PG8_STAGE(PG8_SB(0, 0), cB, voffB); PG8_STAGE(PG8_SB(0, 1), cB + hstep, voffB); PG8_STAGE(PG8_SA(0, 0), cA, voffA); PG8_STAGE(PG8_SA(0, 1), cA + hstep, voffA);
        if (wr == 1) PG8_BAR;
        PG8_WAIT_V(2); PG8_BAR;
        PG8_STAGE(PG8_SB(1, 0), cB + kstep, voffB); PG8_STAGE(PG8_SA(1, 0), cA + kstep, voffA); PG8_STAGE(PG8_SB(1, 1), cB + hstep + kstep, voffB);
        PG8_WAIT_V(6); PG8_BAR;
    } else {
        PG8_STAGE(PG8_SB(0, 0), cB, voffB); PG8_STAGE(PG8_SA(0, 0), cA, voffA); PG8_STAGE(PG8_SB(0, 1), cB + hstep, voffB); PG8_STAGE(PG8_SA(0, 1), cA + hstep, voffA);
        if (wr == 1) PG8_BAR;
        PG8_WAIT_V(4); PG8_BAR;
        PG8_STAGE(PG8_SB(1, 0), cB + kstep, voffB); PG8_STAGE(PG8_SA(1, 0), cA + kstep, voffA); PG8_STAGE(PG8_SB(1, 1), cB + hstep + kstep, voffB);
        PG8_WAIT_V(6); PG8_BAR;
    }
    for (;;) {
        const bool has_next = S.next(ui + 1, nxt);
        const char* nA = has_next ? (const char*)g.A + (size_t)nxt.pm * tstep + (size_t)nxt.k0 * 2 : cA; const char* nB = has_next ? (const char*)g.Bt + (size_t)nxt.pn * tstep + (size_t)nxt.k0 * 2 : cB;
        for (int t = 0; t < nt; t += 2) {
            const bool last = (t == nt - 2);
            const char* a1 = cA + (size_t)(t + 1) * kstep;
            const char* a2 = last ? nA : cA + (size_t)(t + 2) * kstep; const char* b2 = last ? nB : cB + (size_t)(t + 2) * kstep;
            const char* a3 = a2 + kstep; const char* b3 = b2 + kstep;
            if (last && has_next) S.a_ready(nxt);
            if constexpr (SP2) {
            PG8_LDB(B0, 0, 0); PG8_LDB(B1, 0, 1); PG8_SCHED; PG8_LDA(At, 0, 0); PG8_STAGE(PG8_SA(1, 1), a1 + hstep, voffA);
            PG8_WAIT_V(8); PG8_WAIT_L(0); PG8_BAR; PG8_MMA(0, 0, At, B0); PG8_MMA(0, 1, At, B1); PG8_BAR; PG8_SCHED;
            PG8_LDA(At, 0, 1); PG8_STAGE(PG8_SB(0, 0), b2, voffB); PG8_STAGE(PG8_SB(0, 1), b2 + hstep, voffB); PG8_STAGE(PG8_SA(0, 0), a2, voffA);
            PG8_WAIT_V(8); PG8_WAIT_L(0); PG8_BAR; PG8_MMA(1, 0, At, B0); PG8_MMA(1, 1, At, B1); PG8_BAR; PG8_SCHED;
            PG8_LDB(B0, 1, 0); PG8_LDB(B1, 1, 1); PG8_SCHED; PG8_LDA(At, 1, 0); PG8_STAGE(PG8_SA(0, 1), a2 + hstep, voffA);
            PG8_WAIT_V(8); PG8_WAIT_L(0); PG8_BAR; PG8_MMA(0, 0, At, B0); PG8_MMA(0, 1, At, B1); PG8_BAR; PG8_SCHED;
            PG8_LDA(At, 1, 1); PG8_STAGE(PG8_SB(1, 0), b3, voffB); PG8_STAGE(PG8_SB(1, 1), b3 + hstep, voffB); PG8_STAGE(PG8_SA(1, 0), a3, voffA);
            PG8_WAIT_V(8); PG8_WAIT_L(0); PG8_BAR; PG8_MMA(1, 0, At, B0); PG8_MMA(1, 1, At, B1); PG8_BAR; PG8_SCHED;
            } else {
            PG8_LDB(B0, 0, 0); PG8_SCHED; PG8_LDA(At, 0, 0); PG8_STAGE(PG8_SA(1, 1), a1 + hstep, voffA);
            PG8_WAIT_L(8); PG8_BAR; PG8_WAIT_L(0); PG8_MMA(0, 0, At, B0); PG8_BAR; PG8_SCHED;
            PG8_LDB(B1, 0, 1); PG8_STAGE(PG8_SB(0, 0), b2, voffB);
            PG8_BAR; PG8_WAIT_L(0); PG8_MMA(0, 1, At, B1); PG8_BAR;
            PG8_LDA(At, 0, 1); PG8_STAGE(PG8_SA(0, 0), a2, voffA);
            PG8_BAR; PG8_WAIT_L(0); PG8_MMA(1, 0, At, B0); PG8_BAR; PG8_SCHED;
            PG8_STAGE(PG8_SB(0, 1), b2 + hstep, voffB);
            PG8_WAIT_V(6); PG8_BAR; PG8_MMA(1, 1, At, B1); PG8_BAR;
            PG8_LDB(B0, 1, 0); PG8_SCHED; PG8_LDA(At, 1, 0); PG8_STAGE(PG8_SA(0, 1), a2 + hstep, voffA);
            PG8_WAIT_L(8); PG8_BAR; PG8_WAIT_L(0); PG8_MMA(0, 0, At, B0); PG8_BAR; PG8_SCHED;
            PG8_LDB(B1, 1, 1); PG8_STAGE(PG8_SB(1, 0), b3, voffB);
            PG8_BAR; PG8_WAIT_L(0); PG8_MMA(0, 1, At, B1); PG8_BAR;
            PG8_LDA(At, 1, 1); PG8_STAGE(PG8_SA(1, 0), a3, voffA);
            PG8_BAR; PG8_WAIT_L(0); PG8_MMA(1, 0, At, B0); PG8_BAR; PG8_SCHED;
            PG8_STAGE(PG8_SB(1, 1), b3 + hstep, voffB);
            PG8_WAIT_V(6); PG8_BAR; PG8_MMA(1, 1, At, B1); PG8_BAR;
            }
        }
        if constexpr (ALIGN_EPI) { if (wr == 0) PG8_BAR; }
        if constexpr (!Epi::AFTER_DRAIN) { E(acc, cur, wr, wc, fr, fq); S.done(cur); }
        if (!has_next) break;
#pragma unroll
        for (int a = 0; a < 2; ++a)
#pragma unroll
            for (int b = 0; b < 2; ++b)
#pragma unroll
                for (int m = 0; m < 4; ++m)
#pragma unroll
                    for (int n = 0; n < 2; ++n) acc[a][b][m][n] = (f32x4){0.f, 0.f, 0.f, 0.f};
        cur = nxt; cA = nA; cB = nB; ++ui;
        if constexpr (ALIGN_EPI) { if (wr == 1) PG8_BAR; }
    }
    PG8_WAIT_V(0);
    if constexpr (!ALIGN_EPI) { if (wr == 0) PG8_BAR; }
    PG8_BAR;
    if constexpr (Epi::AFTER_DRAIN) { E.fused(acc, cur, wr, wc, fr, fq, lds, wid, lane); S.done(cur); }
#undef PG8_SA
#undef PG8_SB
#undef PG8_STAGE
#undef PG8_LDA
#undef PG8_LDB
#undef PG8_MMA
#undef PG8_WAIT_V
#undef PG8_WAIT_L
#undef PG8_BAR
#undef PG8_SCHED
}
}

constexpr int D = 1024, NB = 8, SEQ = 2048, NS = 16, SSEQ = 64, MP = NB * SEQ, M = MP + NS * SSEQ;
constexpr int DA = 512, DB = 512, DIN = 2048, FF = 3072, FF2 = 6144;
constexpr float EPS = 1e-6f;
constexpr size_t O_Y = 0, O_HP = (size_t)M * D, O_CP = O_HP + NB * DA, O_FP = O_CP + NB * 3 * DA, O_HS = O_FP + NB * 2 * FF2, O_CS = O_HS + NS * DA, O_FS = O_CS + NS * 3 * DA, O_VS = O_FS + NS * 2 * FF2,
                 O_END = O_VS + (size_t)NS * SSEQ * DB;
constexpr size_t MiB = 1u << 20;
constexpr size_t WS_CTL = 0, CTL_ZERO_BYTES = 65536;
constexpr size_t WS_WIN = 2 * MiB, WS_WO = 6 * MiB, WS_WUP = 8 * MiB, WS_WDN = 20 * MiB, WS_XN = 26 * MiB, WS_Z = 60 * MiB, WS_MIX = 128 * MiB, WS_HB = 60 * MiB, WS_F = 162 * MiB,
                 WS_XNB = 230 * MiB, WS_UB = 231 * MiB, WS_AGG = 237 * MiB, WS_WRF = 238 * MiB, WS_END = 239 * MiB,
                 WS_ZP = 162 * MiB  , WS_YP = 162 * MiB  ,
                 WS_FP = 26 * MiB  , WS_UBP = 162 * MiB  ;
constexpr int LDS_BYTES = 147456;

#define GAS __attribute__((address_space(1)))
#define LAS __attribute__((address_space(3)))
typedef unsigned short bf16;
typedef float f32x4 __attribute__((ext_vector_type(4)));
typedef short bf16x8 __attribute__((ext_vector_type(8)));
typedef unsigned v4u __attribute__((ext_vector_type(4)));
typedef unsigned v2u __attribute__((ext_vector_type(2)));
#define LDS_WAIT() asm volatile("s_waitcnt lgkmcnt(0)" ::: "memory")

__device__ __forceinline__ unsigned f2bf(float f) { unsigned u = __builtin_bit_cast(unsigned, f); return (u + 0x7fffu + ((u >> 16) & 1u)) >> 16; }
__device__ __forceinline__ unsigned pk2(float lo, float hi) { return f2bf(lo) | (f2bf(hi) << 16); }
__device__ __forceinline__ float bf2f(bf16 b) { return __builtin_bit_cast(float, (unsigned)b << 16); }
__device__ __forceinline__ float wave_sum(float v) {
#pragma unroll
    for (int o = 1; o < 64; o <<= 1) v += __shfl_xor(v, o);
    return v;
}
__device__ __forceinline__ float sigmoidf_(float z) { return __builtin_amdgcn_rcpf(1.0f + __builtin_amdgcn_exp2f(-1.4426950408889634f * z)); }

__device__ __forceinline__ void p0_transpose_item(const float* W, int K, int N, bf16* WT, bool up_perm, LAS float* scr, int item, int lane) {
    const int nblk = N / 32, kb = item / nblk, nb = item % nblk, k0 = 64 * kb, n0 = 32 * nb;
#pragma unroll 8
    for (int i = 0; i < 32; ++i) { const int kk = 2 * i + (lane >> 5); scr[kk * 33 + (lane & 31)] = W[(size_t)(k0 + kk) * N + n0 + (lane & 31)]; }
    LDS_WAIT(); asm volatile("" ::: "memory");
    int rb = n0; if (up_perm) { const int hi = n0 >= FF ? 1 : 0, cc = n0 - hi * FF; rb = (cc >> 7) * 256 + hi * 128 + (cc & 127); }
    const int c = lane & 7;
#pragma unroll
    for (int j = 0; j < 4; ++j) { const int n = (lane >> 3) + 8 * j; const LAS float* s = scr + (8 * c) * 33 + n;
        v4u o; o.x = pk2(s[0 * 33], s[1 * 33]); o.y = pk2(s[2 * 33], s[3 * 33]); o.z = pk2(s[4 * 33], s[5 * 33]); o.w = pk2(s[6 * 33], s[7 * 33]);
        *(v4u*)(WT + (size_t)(rb + n) * K + k0 + 8 * c) = o; }
    LDS_WAIT(); asm volatile("" ::: "memory");
}

struct P {
    const float *xp, *xs, *st_h, *st_conv, *st_ffn, *g_pre1, *w_in, *w_conv_a, *b_conv_a, *w_r, *b_r, *w_i, *b_i, *lam, *g_out_a, *g_v, *b_v, *w_s, *b_s, *g_out_b, *w_o, *g_post1, *g_pre2, *w_up,
                *w_conv_f, *b_conv_f, *w_down, *g_post2;
    float* out; unsigned char* ws;
};
__device__ __forceinline__ const float* xrow(const P& p, int m) { return m < MP ? p.xp + (size_t)m * D : p.xs + (size_t)(m - MP) * D; }

__device__ __forceinline__ void row_pre1(const P& p, int m, int lane) {
    const f32x4* xr = (const f32x4*)xrow(p, m) + lane; const f32x4* gr = (const f32x4*)p.g_pre1 + lane;
    f32x4 v[4]; float s = 0.f;
#pragma unroll
    for (int j = 0; j < 4; ++j) { v[j] = xr[64 * j]; s += (v[j].x * v[j].x + v[j].y * v[j].y) + (v[j].z * v[j].z + v[j].w * v[j].w); }
    const float rs = 1.0f / sqrtf(wave_sum(s) * (1.f / D) + EPS);
    unsigned long long* o8 = (unsigned long long*)((bf16*)(p.ws + WS_XN) + (size_t)m * D) + lane;
#pragma unroll
    for (int j = 0; j < 4; ++j) { const f32x4 g = gr[64 * j]; o8[64 * j] = (unsigned long long)pk2(v[j].x * rs * g.x, v[j].y * rs * g.y) | ((unsigned long long)pk2(v[j].z * rs * g.z, v[j].w * rs * g.w) << 32); }
}
__device__ __forceinline__ void row_post1(const P& p, int m, int lane) {
    const f32x4* xr = (const f32x4*)xrow(p, m) + lane; f32x4* yr = (f32x4*)(p.out + O_Y + (size_t)m * D) + lane;
    const f32x4* g1 = (const f32x4*)p.g_post1 + lane; const f32x4* g2 = (const f32x4*)p.g_pre2 + lane;
    f32x4 y[4]; float s = 0.f;
#pragma unroll
    for (int j = 0; j < 4; ++j) {
        if (m < MP) y[j] = yr[64 * j];
        else { const f32x4* yp = (const f32x4*)((const float*)(p.ws + WS_YP) + (size_t)(m - MP) * D) + lane + 64 * j; y[j] = (yp[0] + yp[262144]) + (yp[2 * 262144] + yp[3 * 262144]); }
        s += (y[j].x * y[j].x + y[j].y * y[j].y) + (y[j].z * y[j].z + y[j].w * y[j].w); }
    const float rs = 1.0f / sqrtf(wave_sum(s) * (1.f / D) + EPS); float s2 = 0.f;
#pragma unroll
    for (int j = 0; j < 4; ++j) { y[j] = xr[64 * j] + y[j] * rs * g1[64 * j]; yr[64 * j] = y[j]; s2 += (y[j].x * y[j].x + y[j].y * y[j].y) + (y[j].z * y[j].z + y[j].w * y[j].w); }
    const float rs2 = 1.0f / sqrtf(wave_sum(s2) * (1.f / D) + EPS);
    unsigned long long* o8 = (unsigned long long*)((bf16*)(p.ws + WS_XN) + (size_t)m * D) + lane;
    unsigned long long* b8 = nullptr;
    if (m < MP - 64 && (m & 63) >= 62) b8 = (unsigned long long*)((bf16*)(p.ws + WS_XNB) + (size_t)(2 * ((m >> 6) + 1) + (m & 63) - 62) * D) + lane;
#pragma unroll
    for (int j = 0; j < 4; ++j) { const f32x4 g = g2[64 * j]; const unsigned long long w = (unsigned long long)pk2(y[j].x * rs2 * g.x, y[j].y * rs2 * g.y) | ((unsigned long long)pk2(y[j].z * rs2 * g.z, y[j].w * rs2 * g.w) << 32);
        o8[64 * j] = w; if (b8) b8[64 * j] = w; }
}
__device__ __forceinline__ void row_post2(const P& p, int m, int lane) {
    const f32x4* fr = (const f32x4*)((const float*)(p.ws + WS_F) + (size_t)m * D) + lane; f32x4* yr = (f32x4*)(p.out + O_Y + (size_t)m * D) + lane;
    const f32x4* g1 = (const f32x4*)p.g_post2 + lane;
    f32x4 y[4]; float s = 0.f;
#pragma unroll
    for (int j = 0; j < 4; ++j) {
        if (m < MP) y[j] = fr[64 * j];
        else { const f32x4* fp = (const f32x4*)((const float*)(p.ws + WS_FP) + (size_t)(m - MP) * D) + lane + 64 * j;
            y[j] = ((fp[0] + fp[262144]) + (fp[2 * 262144] + fp[3 * 262144])) + ((fp[4 * 262144] + fp[5 * 262144]) + (fp[6 * 262144] + fp[7 * 262144])); }
        s += (y[j].x * y[j].x + y[j].y * y[j].y) + (y[j].z * y[j].z + y[j].w * y[j].w); }
    const float rs = 1.0f / sqrtf(wave_sum(s) * (1.f / D) + EPS);
#pragma unroll
    for (int j = 0; j < 4; ++j) yr[64 * j] = yr[64 * j] + y[j] * rs * g1[64 * j];
}

constexpr int MA_WL = 10752, MA_YS = 8 * MA_WL;
template <bool FINAL>
__device__ __forceinline__ void mixer_a_item(const P& p, LAS unsigned char* lds, int q, int wave, int lane) {
    const bool smp = q >= 256; const int b = q >> 5, cc = q & 31, sidx = q - 256;
    const int row0 = smp ? MP + sidx * SSEQ : b * SEQ + cc * 64;
    const int c = wave * 64 + lane;
    const bf16* Z = (const bf16*)(p.ws + WS_Z);
    float* AGG = (float*)(p.ws + WS_AGG);
    LAS unsigned char* wl = lds + wave * MA_WL;
    LAS bf16* XC = (LAS bf16*)wl;
    LAS float* RB = (LAS float*)(wl + 2560);
    LAS float* IB = (LAS float*)(wl + 2560 + 4096);
    LAS float* YS = (LAS float*)(lds + MA_YS);
    bf16x8 BR[2][4], BI[2][4];
    { const bf16x8* wf = (const bf16x8*)(p.ws + WS_WRF) + (size_t)wave * 8 * 64 + lane;
#pragma unroll
      for (int ks = 0; ks < 2; ++ks)
#pragma unroll
        for (int nt = 0; nt < 4; ++nt) { BR[ks][nt] = wf[(ks * 4 + nt) * 64]; BI[ks][nt] = wf[(size_t)8 * 8 * 64 + (ks * 4 + nt) * 64]; } }
    const float cw0 = p.w_conv_a[c], cw1 = p.w_conv_a[DA + c], cw2 = p.w_conv_a[2 * DA + c], cw3 = p.w_conv_a[3 * DA + c], cb = p.b_conv_a[c];
    const float br = p.b_r[c], bi = p.b_i[c];
    const float m8sp = -8.0f * log1pf(expf(-p.lam[c]));
    float xm3, xm2, xm1, h;
    if (smp) { const float* sc = p.st_conv + (size_t)sidx * 3 * DA; xm3 = sc[c]; xm2 = sc[DA + c]; xm1 = sc[2 * DA + c]; h = FINAL ? p.st_h[(size_t)sidx * DA + c] : 0.f; }
    else if (cc == 0) { xm3 = xm2 = xm1 = 0.f; h = 0.f; }
    else { const bf16* zp = Z + (size_t)(row0 - 3) * DIN + DA + c; xm3 = bf2f(zp[0]); xm2 = bf2f(zp[DIN]); xm1 = bf2f(zp[2 * DIN]); h = 0.f;
        if (FINAL) { const float* ag = AGG + (size_t)(b * 32) * 2 * DA + c; for (int k = 0; k < cc; ++k) h = ag[(size_t)k * 2 * DA] * h + ag[(size_t)k * 2 * DA + DA]; } }
    const bool first = !smp && cc == 0;
    float slog = 0.f;
    bf16* MIX = (bf16*)(p.ws + WS_MIX);
    const f32x4 ga = *(const f32x4*)(p.g_out_a + lane * 8), gb = *(const f32x4*)(p.g_out_a + lane * 8 + 4);
#pragma unroll 1
    for (int sc = 0; sc < 4; ++sc) {
        float xc[16];
        const bf16* zr = Z + (size_t)(row0 + sc * 16) * DIN + c;
#pragma unroll
        for (int tt = 0; tt < 16; ++tt) { const float xin = bf2f(zr[(size_t)tt * DIN + DA]);
            const float v = cb + cw0 * xm3 + cw1 * xm2 + cw2 * xm1 + cw3 * xin; xm3 = xm2; xm2 = xm1; xm1 = xin; xc[tt] = v; XC[tt * 72 + lane] = (bf16)f2bf(v); }
        LDS_WAIT();
        const bf16x8 a0 = *(const LAS bf16x8*)(XC + (lane & 15) * 72 + (lane >> 4) * 8), a1 = *(const LAS bf16x8*)(XC + (lane & 15) * 72 + 32 + (lane >> 4) * 8);
#pragma unroll
        for (int nt = 0; nt < 4; ++nt) { pg8::f32x4 ar = {0.f, 0.f, 0.f, 0.f}, ai = {0.f, 0.f, 0.f, 0.f};
            ar = __builtin_amdgcn_mfma_f32_16x16x32_bf16(a0, BR[0][nt], ar, 0, 0, 0); ar = __builtin_amdgcn_mfma_f32_16x16x32_bf16(a1, BR[1][nt], ar, 0, 0, 0);
            ai = __builtin_amdgcn_mfma_f32_16x16x32_bf16(a0, BI[0][nt], ai, 0, 0, 0); ai = __builtin_amdgcn_mfma_f32_16x16x32_bf16(a1, BI[1][nt], ai, 0, 0, 0);
#pragma unroll
            for (int r = 0; r < 4; ++r) { RB[((lane >> 4) * 4 + r) * 64 + nt * 16 + (lane & 15)] = ar[r]; IB[((lane >> 4) * 4 + r) * 64 + nt * 16 + (lane & 15)] = ai[r]; } }
        LDS_WAIT();
        if (FINAL && sc > 0) __syncthreads();
#pragma unroll
        for (int tt = 0; tt < 16; ++tt) {
            const float rg = sigmoidf_(RB[tt * 64 + lane] + br), ig = sigmoidf_(IB[tt * 64 + lane] + bi);
            const float la = m8sp * rg; const float a = __builtin_amdgcn_exp2f(1.4426950408889634f * la);
            float mult = sqrtf(-expm1f(2.0f * la)); if (first && sc == 0 && tt == 0) mult = 1.0f;
            h = a * h + mult * (ig * xc[tt]); slog += la;
            if (FINAL) { const float g = bf2f(zr[(size_t)tt * DIN]); YS[tt * DA + c] = h * pg8::gelu_tanh(g); }
        }
        LDS_WAIT();
        if (FINAL) {
            __syncthreads();
#pragma unroll
            for (int tj = 0; tj < 2; ++tj) { const int t = wave * 2 + tj;
                const f32x4 va = *(const LAS f32x4*)(YS + t * DA + lane * 8), vb = *(const LAS f32x4*)(YS + t * DA + lane * 8 + 4);
                const float ss = wave_sum((va.x * va.x + va.y * va.y) + (va.z * va.z + va.w * va.w) + (vb.x * vb.x + vb.y * vb.y) + (vb.z * vb.z + vb.w * vb.w));
                const float rs = 1.0f / sqrtf(ss * (1.f / DA) + EPS);
                v4u o; o.x = pk2(va.x * rs * ga.x, va.y * rs * ga.y); o.y = pk2(va.z * rs * ga.z, va.w * rs * ga.w); o.z = pk2(vb.x * rs * gb.x, vb.y * rs * gb.y); o.w = pk2(vb.z * rs * gb.z, vb.w * rs * gb.w);
                *(v4u*)(MIX + (size_t)(row0 + sc * 16 + t) * D + lane * 8) = o; }
            LDS_WAIT();
        }
    }
    if (!FINAL) { AGG[(size_t)q * 2 * DA + c] = expf(slog); AGG[(size_t)q * 2 * DA + DA + c] = h; return; }
    if (smp || cc == 31) {
        float* oh = smp ? p.out + O_HS + (size_t)sidx * DA : p.out + O_HP + (size_t)b * DA; oh[c] = h;
        float* oc = smp ? p.out + O_CS + (size_t)sidx * 3 * DA : p.out + O_CP + (size_t)b * 3 * DA; oc[c] = xm3; oc[DA + c] = xm2; oc[2 * DA + c] = xm1;
    }
    __syncthreads();
}

constexpr int VP = 132;
__device__ __forceinline__ void mixer_b_item(const P& p, LAS unsigned char* lds, int k, int wave, int lane) {
    const bool smp = k >= 128; const int sidx = k - 128; const int L = smp ? 64 : 128; const int row0 = smp ? MP + sidx * SSEQ : k * 128;
    const bf16* Z = (const bf16*)(p.ws + WS_Z);
    LAS bf16* VNt = (LAS bf16*)lds;
    const int RW = L / 8;
    {
    float gv[8], bv[8];
#pragma unroll
    for (int e = 0; e < 8; ++e) { gv[e] = p.g_v[e * 64 + lane]; bv[e] = p.b_v[e * 64 + lane]; }
#pragma unroll 1
    for (int jj = 0; jj < RW; ++jj) { const int j = wave * RW + jj; const bf16* zr = Z + (size_t)(row0 + j) * DIN + 3 * DA;
        float v[8]; float s = 0.f;
#pragma unroll
        for (int e = 0; e < 8; ++e) { v[e] = bf2f(zr[e * 64 + lane]); s += v[e]; }
        const float mu = wave_sum(s) * (1.f / DB); float s2 = 0.f;
#pragma unroll
        for (int e = 0; e < 8; ++e) { v[e] -= mu; s2 += v[e] * v[e]; }
        const float rstd = 1.0f / sqrtf(wave_sum(s2) * (1.f / DB) + EPS);
#pragma unroll
        for (int e = 0; e < 8; ++e) { const float vn = v[e] * rstd * gv[e] + bv[e]; VNt[(e * 64 + lane) * VP + j] = (bf16)f2bf(vn);
            if (smp) p.out[O_VS + ((size_t)sidx * SSEQ + j) * DB + e * 64 + lane] = vn; }
    }
    }
    __syncthreads();
    if (wave * 16 < L) {
        const int i0 = wave * 16, nks = (smp || i0 < 64) ? 2 : 4;
        const int il = lane & 15, kg = lane >> 4; const int row = row0 + i0 + il;
        bf16* MIX = (bf16*)(p.ws + WS_MIX);
        float ss = 0.f, rs = 0.f;
#pragma unroll 1
        for (int pass = 0; pass < 2; ++pass) {
#pragma unroll 1
            for (int hh = 0; hh < 4; ++hh) {
                bf16x8 wf[4];
#pragma unroll
                for (int ks = 0; ks < 4; ++ks) { wf[ks] = (bf16x8){0, 0, 0, 0, 0, 0, 0, 0};
                    if (ks < nks) { const float* wp = p.w_s + ((size_t)hh * 128 + i0 + il) * 128 + ks * 32 + kg * 8; const f32x4 w0 = *(const f32x4*)wp, w1 = *(const f32x4*)(wp + 4);
                        wf[ks][0] = (short)f2bf(w0.x); wf[ks][1] = (short)f2bf(w0.y); wf[ks][2] = (short)f2bf(w0.z); wf[ks][3] = (short)f2bf(w0.w);
                        wf[ks][4] = (short)f2bf(w1.x); wf[ks][5] = (short)f2bf(w1.y); wf[ks][6] = (short)f2bf(w1.z); wf[ks][7] = (short)f2bf(w1.w); } }
                const float bs = p.b_s[hh * 128 + i0 + il];
#pragma unroll 2
                for (int dt = 0; dt < 8; ++dt) { pg8::f32x4 a = {0.f, 0.f, 0.f, 0.f};
#pragma unroll
                    for (int ks = 0; ks < 4; ++ks) if (ks < nks) { const LAS bf16* vp = VNt + (hh * 128 + dt * 16 + il) * VP + ks * 32 + kg * 8;
                        typedef short s16x4 __attribute__((ext_vector_type(4)));
                        const s16x4 lo = *(const LAS s16x4*)vp, hi = *(const LAS s16x4*)(vp + 4);
                        const bf16x8 af = {lo[0], lo[1], lo[2], lo[3], hi[0], hi[1], hi[2], hi[3]};
                        a = __builtin_amdgcn_mfma_f32_16x16x32_bf16(af, wf[ks], a, 0, 0, 0); }
                    const int d0 = hh * 128 + dt * 16 + kg * 4; const pg8::f32x4 u4 = pg8::bf4_to_f4(Z + (size_t)row * DIN + 2 * DA + d0);
                    const pg8::f32x4 yv = u4 * (a + bs);
                    if (pass == 0) ss += (yv[0] * yv[0] + yv[1] * yv[1]) + (yv[2] * yv[2] + yv[3] * yv[3]);
                    else { const f32x4 g = *(const f32x4*)(p.g_out_b + d0);
                        v2u o; o.x = pk2(yv[0] * rs * g.x, yv[1] * rs * g.y); o.y = pk2(yv[2] * rs * g.z, yv[3] * rs * g.w);
                        *(v2u*)(MIX + (size_t)row * D + DA + d0) = o; }
                }
            }
            if (pass == 0) { ss += __shfl_xor(ss, 16); ss += __shfl_xor(ss, 32); rs = 1.0f / sqrtf(ss * (1.f / DB) + EPS); }
        }
    }
    __syncthreads();
}


#define XB_TMO      128
#define XB_XCNT(j)  (256  + 64 * (j))
#define XB_XSUB(j)  (1280 + 64 * (j))
#define XB_XGEN(j)  (2304 + 64 * (j))
#define XB_TOP      3328
#define XB_TOPGEN   3392
#define XCD_BAR_WORDS 3456
#define XB_SPIN_CAP (1u << 18)

__device__ __forceinline__ unsigned xb_ld(unsigned* p)              { return __hip_atomic_load(p, __ATOMIC_RELAXED, __HIP_MEMORY_SCOPE_AGENT); }
__device__ __forceinline__ unsigned xb_add(unsigned* p, unsigned v) { return __hip_atomic_fetch_add(p, v, __ATOMIC_RELAXED, __HIP_MEMORY_SCOPE_AGENT); }
__device__ __forceinline__ unsigned xb_xcc_id() { return (unsigned)__builtin_amdgcn_s_getreg((3 << 11) | 20) & 0xFu; }
#define XB_SPIN(cond, bar) do { unsigned _sp = 0; while (cond) { __builtin_amdgcn_s_sleep(1); \
    if ((++_sp & 255u) == 0u) { if (xb_ld(&(bar)[XB_TMO])) break; if (_sp > XB_SPIN_CAP) { atomicAdd(&(bar)[XB_TMO], 1u); break; } } } } while (0)

struct XcdBarrier {
    unsigned* bar; unsigned x;
    volatile LAS unsigned* st;
};

__device__ __forceinline__ XcdBarrier xcd_barrier_post(unsigned* bar, volatile LAS unsigned* st) {
    XcdBarrier b; b.bar = bar; b.x = xb_xcc_id(); b.st = st;
    if (threadIdx.x == 0) (void)xb_add(&bar[XB_XCNT(b.x)], 1u);
    return b;
}
__device__ __forceinline__ void xcd_barrier_complete(unsigned* bar, unsigned x, unsigned& nloc, unsigned& nx) {
    const unsigned G = gridDim.x * gridDim.y * gridDim.z;
    unsigned sum, cnt, mine, sp = 0u;
    for (;;) {
        sum = 0u; cnt = 0u; mine = 0u;
#pragma unroll
        for (unsigned j = 0; j < 16; ++j) { const unsigned c = xb_ld(&bar[XB_XCNT(j)]); sum += c; cnt += (c > 0u) ? 1u : 0u; mine = (j == x) ? c : mine; }
        if (sum == G) break;
        __builtin_amdgcn_s_sleep(1);
        if ((++sp & 255u) == 0u) { if (xb_ld(&bar[XB_TMO])) break; if (sp > XB_SPIN_CAP) { atomicAdd(&bar[XB_TMO], 1u); break; } }
    }
    nloc = mine > 0u ? mine : 1u; nx = cnt > 0u ? cnt : 1u;
}

__device__ __forceinline__ void xcd_barrier(const XcdBarrier& b) {
    asm volatile("s_waitcnt vmcnt(0)" ::: "memory");
    __syncthreads();
    if (threadIdx.x == 0) {
        unsigned* bar = b.bar;
        __builtin_amdgcn_s_waitcnt(0);
        unsigned nloc = b.st[0], nx = b.st[1];
        if (nloc == 0u) { xcd_barrier_complete(bar, b.x, nloc, nx); b.st[0] = nloc; b.st[1] = nx; }
        const unsigned old = xb_add(&bar[XB_XSUB(b.x)], 1u);
        const unsigned gen = old / nloc;
        if (old + 1u == (gen + 1u) * nloc) {
            __builtin_amdgcn_fence(__ATOMIC_RELEASE, "agent");
            asm volatile("s_waitcnt vmcnt(0)" ::: "memory");
            const unsigned og = xb_add(&bar[XB_TOP], 1u);
            const unsigned tg = og / nx;
            if (og + 1u == (tg + 1u) * nx) xb_add(&bar[XB_TOPGEN], 1u);
            else XB_SPIN(xb_ld(&bar[XB_TOPGEN]) == tg, bar);
            __builtin_amdgcn_fence(__ATOMIC_ACQUIRE, "agent");
            xb_add(&bar[XB_XGEN(b.x)], 1u);
            asm volatile("s_waitcnt vmcnt(0)" ::: "memory");
        } else {
            XB_SPIN(xb_ld(&bar[XB_XGEN(b.x)]) == gen, bar);
            __builtin_amdgcn_fence(__ATOMIC_ACQUIRE, "agent");
            asm volatile("s_waitcnt vmcnt(0)" ::: "memory");
        }
    }
    __syncthreads();
}

struct Args { const float* in[28]; float* out; unsigned char* ws; int ph_lo, ph_hi; };
constexpr int NPH = 10;
__global__ void __launch_bounds__(512, 2) fwd(Args args) {
    extern __shared__ __attribute__((aligned(16))) unsigned char lds_raw[];
    LAS unsigned char* lds = (LAS unsigned char*)lds_raw;
    const int tid = threadIdx.x, lane = tid & 63, wave = __builtin_amdgcn_readfirstlane(tid >> 6);
    const int G = gridDim.x, bx = blockIdx.x;
    const int gw = bx * 8 + wave, NGW = G * 8;
    P p;
    p.xp = args.in[0]; p.xs = args.in[1]; p.st_h = args.in[2]; p.st_conv = args.in[3]; p.st_ffn = args.in[4]; p.g_pre1 = args.in[5]; p.w_in = args.in[6]; p.w_conv_a = args.in[7]; p.b_conv_a = args.in[8];
    p.w_r = args.in[9]; p.b_r = args.in[10]; p.w_i = args.in[11]; p.b_i = args.in[12]; p.lam = args.in[13]; p.g_out_a = args.in[14]; p.g_v = args.in[15]; p.b_v = args.in[16]; p.w_s = args.in[17]; p.b_s = args.in[18];
    p.g_out_b = args.in[19]; p.w_o = args.in[20]; p.g_post1 = args.in[21]; p.g_pre2 = args.in[22]; p.w_up = args.in[23]; p.w_conv_f = args.in[24]; p.b_conv_f = args.in[25]; p.w_down = args.in[26]; p.g_post2 = args.in[27];
    p.out = args.out; p.ws = args.ws;
    unsigned char* ws = args.ws;
    bf16 *Wt_in = (bf16*)(ws + WS_WIN), *Wt_o = (bf16*)(ws + WS_WO), *Wt_up = (bf16*)(ws + WS_WUP), *Wt_dn = (bf16*)(ws + WS_WDN);
    bf16 *XN = (bf16*)(ws + WS_XN), *Zb = (bf16*)(ws + WS_Z), *MIX = (bf16*)(ws + WS_MIX), *HB = (bf16*)(ws + WS_HB), *XNB = (bf16*)(ws + WS_XNB), *UB = (bf16*)(ws + WS_UB);
    float* Fb = (float*)(ws + WS_F);
    const int lo = args.ph_lo, hi = args.ph_hi;
    volatile LAS unsigned* MISC = (volatile LAS unsigned*)(lds + LDS_BYTES - 64);
    if (tid < 16) MISC[tid] = 0u;
    __syncthreads();
    XcdBarrier bar = xcd_barrier_post((unsigned*)(ws + WS_CTL) + 1024, MISC);
#ifndef PHASE_MASK
#define PHASE_MASK 0x3ff
#endif
#define IN(k) ((((PHASE_MASK) >> (k)) & 1) && lo <= (k) && (k) < hi)
#ifndef SYNC_REPS
#define SYNC_REPS 1
#endif
#ifndef MIX_REPS
#define MIX_REPS 1
#endif
#define SEAM(k) do { if (IN(k) && IN((k) + 1)) { for (int r_ = 0; r_ < SYNC_REPS; ++r_) xcd_barrier(bar); } } while (0)

    if (IN(0)) {
        LAS float* scr = (LAS float*)(lds + wave * 16384);
        constexpr int I_IN = (D / 64) * (DIN / 32), I_O = (D / 64) * (D / 32), I_UP = (D / 64) * (FF2 / 32), I_DN = (FF / 64) * (D / 32);
        for (int it = gw; it < I_IN + I_O + I_UP + I_DN; it += NGW) { int r = it;
            if (r < I_IN) { p0_transpose_item(p.w_in, D, DIN, Wt_in, false, scr, r, lane); continue; } r -= I_IN;
            if (r < I_O) { p0_transpose_item(p.w_o, D, D, Wt_o, false, scr, r, lane); continue; } r -= I_O;
            if (r < I_UP) { p0_transpose_item(p.w_up, D, FF2, Wt_up, true, scr, r, lane); continue; } r -= I_UP;
            p0_transpose_item(p.w_down, FF, D, Wt_dn, false, scr, r, lane); }
        for (int idx = bx * 512 + tid; idx < 2 * 8 * 8 * 64 * 8; idx += G * 512) { const int j = idx & 7, ln = (idx >> 3) & 63, f = (idx >> 9) & 7, hh = (idx >> 12) & 7, mat = idx >> 15;
            const int d = (f >> 2) * 32 + (ln >> 4) * 8 + j, e = (f & 3) * 16 + (ln & 15);
            ((bf16*)(ws + WS_WRF))[idx] = (bf16)f2bf((mat ? p.w_i : p.w_r)[(size_t)hh * 4096 + d * 64 + e]); }
        for (int m = gw; m < M; m += NGW) row_pre1(p, m, lane);
        __syncthreads();
    }
    SEAM(0);
    if (IN(1)) { pg8::Gemm g{XN, Wt_in, MP, DIN, D, D}; pg8::StaticOrder S; S.init(MP, DIN, G, bx);
        pg8::EpiBf16<0> E{Zb, DIN, nullptr, 0, 0, 1.f};
        pg8::gemm_phase<pg8::EpiBf16<0>, pg8::StaticOrder, true, true>(lds, g, S, E);
        pg8::Gemm g2{XN, Wt_in, M, DIN, 256, D}; pg8::SplitOrder S2; S2.init(64, 4, 8, 4, 256, bx);
        pg8::EpiF32 E2{(float*)(ws + WS_ZP), DIN, nullptr, 64, (size_t)1024 * DIN};
        pg8::gemm_phase<pg8::EpiF32, pg8::SplitOrder, true, true>(lds, g2, S2, E2); }
    SEAM(1);
    for (int rep_ = 0; rep_ < MIX_REPS; ++rep_) {
    if (IN(2)) {
        for (int idx = bx * 512 + tid; idx < 1024 * (DIN / 8); idx += G * 512) {
            const f32x4* zp = (const f32x4*)(ws + WS_ZP) + (size_t)idx * 2; constexpr size_t SS = (size_t)1024 * DIN / 4;
            const f32x4 a = (zp[0] + zp[SS]) + (zp[2 * SS] + zp[3 * SS]), b2 = (zp[1] + zp[SS + 1]) + (zp[2 * SS + 1] + zp[3 * SS + 1]);
            v4u o; o.x = pk2(a.x, a.y); o.y = pk2(a.z, a.w); o.z = pk2(b2.x, b2.y); o.w = pk2(b2.z, b2.w);
            *((v4u*)(Zb + (size_t)MP * DIN) + idx) = o; }
        for (int it = bx; it < NB * 31; it += G) { const int q = (it / 31) * 32 + it % 31; mixer_a_item<false>(p, lds, q, wave, lane); } }
    SEAM(2);
    if (IN(3)) { for (int it = bx; it < 272 + 144; it += G) { if (it < 272) mixer_a_item<true>(p, lds, it, wave, lane); else mixer_b_item(p, lds, it - 272, wave, lane); } }
    SEAM(3);
    }
    if (IN(4)) { pg8::Gemm g{MIX, Wt_o, MP, D, D, D}; pg8::StaticOrder S; S.init(MP, D, G, bx);
        pg8::EpiF32 E{p.out + O_Y, D, nullptr, 0, 0};
        pg8::gemm_phase<pg8::EpiF32, pg8::StaticOrder, true, true>(lds, g, S, E);
        pg8::Gemm g2{MIX, Wt_o, M, D, 256, D}; pg8::SplitOrder S2; S2.init(64, 4, 4, 4, 256, bx);
        pg8::EpiF32 E2{(float*)(ws + WS_YP), D, nullptr, 64, (size_t)1024 * D};
        pg8::gemm_phase<pg8::EpiF32, pg8::SplitOrder, true, true>(lds, g2, S2, E2); }
    SEAM(4);
    if (IN(5)) { for (int m = gw; m < M; m += NGW) row_post1(p, m, lane); }
    SEAM(5);
    if (IN(6)) { pg8::Gemm g{XNB, Wt_up, 512, FF2, 256, D}; pg8::SplitOrder S; S.init(0, 2, 24, 4, 256, bx);
        pg8::EpiF32 E{(float*)(ws + WS_UBP), FF2, nullptr, 0, (size_t)512 * FF2};
        pg8::gemm_phase<pg8::EpiF32, pg8::SplitOrder, true, true>(lds, g, S, E); }
    SEAM(6);
    if (IN(7)) { pg8::Gemm g{XN, Wt_up, M, FF2, D, D}; pg8::StaticOrder S; S.init(M, FF2, G, bx);
        pg8::EpiConvGeglu E{HB, (const float*)(ws + WS_UBP), p.st_ffn, p.w_conv_f, p.b_conv_f, p.out + O_FP, p.out + O_FS};
        pg8::gemm_phase<pg8::EpiConvGeglu, pg8::StaticOrder, true, true>(lds, g, S, E); }
    SEAM(7);
    if (IN(8)) { pg8::Gemm g{HB, Wt_dn, MP, D, FF, FF}; pg8::StaticOrder S; S.init(MP, D, G, bx);
        pg8::EpiF32 E{Fb, D, nullptr, 0, 0};
        pg8::gemm_phase<pg8::EpiF32, pg8::StaticOrder, true, true>(lds, g, S, E);
        pg8::Gemm g2{HB, Wt_dn, M, D, 384, FF}; pg8::SplitOrder S2; S2.init(64, 4, 4, 8, 384, bx);
        pg8::EpiF32 E2{(float*)(ws + WS_FP), D, nullptr, 64, (size_t)1024 * D};
        pg8::gemm_phase<pg8::EpiF32, pg8::SplitOrder, true, true>(lds, g2, S2, E2); }
    SEAM(8);
    if (IN(9)) { for (int m = gw; m < M; m += NGW) row_post2(p, m, lane); }
#undef IN
#undef SEAM
}

extern "C" void kernel_launch(void* const* d_in, const int* in_sizes, int n_in, void* d_out, int out_size, void* d_ws, size_t ws_size, hipStream_t stream) {
    static int grid = 0;
    if (grid == 0) {
        if (n_in != 28 || (size_t)out_size != O_END || ws_size < WS_END) { fprintf(stderr, "kernel_launch: unexpected shapes: n_in %d out %d ws %zu\n", n_in, out_size, ws_size); grid = -1; return; }
        int dev = 0, cus = 0, per_cu = 0;
        if (hipGetDevice(&dev) != hipSuccess || hipDeviceGetAttribute(&cus, hipDeviceAttributeMultiprocessorCount, dev) != hipSuccess) { grid = -1; return; }
        if (hipFuncSetAttribute((const void*)fwd, hipFuncAttributeMaxDynamicSharedMemorySize, LDS_BYTES) != hipSuccess) { fprintf(stderr, "kernel_launch: hipFuncSetAttribute failed\n"); grid = -1; return; }
        if (hipOccupancyMaxActiveBlocksPerMultiprocessor(&per_cu, (const void*)fwd, 512, LDS_BYTES) != hipSuccess || per_cu < 1) { fprintf(stderr, "kernel_launch: occupancy query failed (%d)\n", per_cu); (void)hipGetLastError(); per_cu = 1; }
        grid = cus * 1;
        if (grid > 256) grid = 256;
    }
    if (grid < 0) return;
    if (hipMemsetAsync((char*)d_ws + WS_CTL, 0, CTL_ZERO_BYTES, stream) != hipSuccess) { fprintf(stderr, "kernel_launch: memset failed\n"); return; }
    Args a{};
    for (int i = 0; i < 28; ++i) a.in[i] = (const float*)d_in[i];
    a.out = (float*)d_out; a.ws = (unsigned char*)d_ws; a.ph_lo = 0; a.ph_hi = NPH;
    void* kargs[] = {&a};
    const hipError_t e = hipLaunchCooperativeKernel((const void*)fwd, dim3(grid), dim3(512), kargs, LDS_BYTES, stream);
    if (e != hipSuccess) fprintf(stderr, "kernel_launch: cooperative launch failed: %s (grid %d)\n", hipGetErrorString(e), grid);
}
```

```cpp
#include <hip/hip_runtime.h>
#include <cstdio>
#include <cstdint>
namespace pg8 {
#define PG8_LAS __attribute__((address_space(3)))
typedef unsigned short bf16_t;
typedef short bf16x8 __attribute__((ext_vector_type(8)));
typedef float f32x4 __attribute__((ext_vector_type(4)));
typedef unsigned u32x4 __attribute__((ext_vector_type(4)));
constexpr int BM = 256, BK = 64, HALF = 128, HTB = HALF * BK * 2  , STAGE_BYTES = 8 * HTB, NXCD = 8, WGM = 8;

__host__ __device__ __forceinline__ int lds_byte(int r, int c) { const int st = (r >> 4) * 2 + (c >> 5), rr = r & 15, cc = c & 31, ob = rr * 64 + cc * 2; return st * 1024 + (ob ^ (((ob >> 9) & 1) << 5)); }
__host__ __device__ __forceinline__ void stage_rc(int b, int& R, int& C) { const int st = b / 1024, sb = b % 1024, swz = sb ^ (((sb >> 9) & 1) << 5); R = (st >> 1) * 16 + swz / 64; C = (st & 1) * 32 + (swz % 64) / 2; }
__host__ __device__ __forceinline__ int perm32(int rho) { const int n = rho >> 4, i = rho & 15; return 8 * (i >> 2) + 4 * n + (i & 3); }

struct Unit { int pm, pn, k0, ks; };
struct Gemm { const bf16_t* A; const bf16_t* Bt; int M, N, K, ld; };

struct StaticOrder {
    int nM, nN, nwg, G, c;
    __host__ __device__ void init(int M, int N, int G_, int c_) { nM = M / BM; nN = N / BM; nwg = nM * nN; G = G_; c = c_; }
    __host__ __device__ bool next(int i, Unit& u) const {
        const long L = (long)i * G + c; if (L >= nwg) return false;
        int wgid = (int)L; { const int q = nwg / NXCD, r = nwg % NXCD, xcd = wgid % NXCD, off = wgid / NXCD; wgid = (xcd < r ? xcd * (q + 1) : r * (q + 1) + (xcd - r) * q) + off; }
        const int nig = WGM * nN, gid = wgid / nig, fm = gid * WGM, gsz = (nM - fm) < WGM ? (nM - fm) : WGM;
        u.pm = fm + ((wgid % nig) % gsz); u.pn = (wgid % nig) / gsz; u.k0 = 0; u.ks = 0; return true;
    }
    __device__ __forceinline__ void a_ready(const Unit&) const {}
    __device__ __forceinline__ void done(const Unit&) const {}
};

struct SplitOrder {
    int pm0, nP, nN, nS, Kc, c;
    __host__ __device__ void init(int pm0_, int nP_, int nN_, int nS_, int Kc_, int c_) { pm0 = pm0_; nP = nP_; nN = nN_; nS = nS_; Kc = Kc_; c = c_; }
    __host__ __device__ bool next(int i, Unit& u) const {
        if (i > 0 || c >= nP * nN * nS) return false;
        u.ks = c % nS; u.pn = (c / nS) % nN; u.pm = pm0 + c / (nS * nN); u.k0 = u.ks * Kc; return true;
    }
    __device__ __forceinline__ void a_ready(const Unit&) const {}
    __device__ __forceinline__ void done(const Unit&) const {}
};
__device__ __forceinline__ unsigned cvt_pk_bf16(float lo, float hi) { unsigned r; asm volatile("v_cvt_pk_bf16_f32 %0, %1, %2" : "=v"(r) : "v"(lo), "v"(hi)); return r; }
typedef float f32x2 __attribute__((ext_vector_type(2)));
__device__ __forceinline__ f32x2 gelu_pk(f32x2 v) {
    const f32x2 av = __builtin_elementwise_abs(v), d = av * 0.2316418882f + 1.0f;
    f32x2 t; t.x = __builtin_amdgcn_rcpf(d.x); t.y = __builtin_amdgcn_rcpf(d.y);
    f32x2 q = t * 0.5307027145f + (-0.7265760135f); q = q * t + 0.7107068705f; q = q * t + (-0.142248368f); q = q * t + 0.127414796f; q = q * t;
    const f32x2 s = (v * v) * (-0.72134752044f);
    f32x2 e; e.x = __builtin_amdgcn_exp2f(s.x); e.y = __builtin_amdgcn_exp2f(s.y);
    const f32x2 m = v * (q * e), r = v - m;
    f32x2 o; o.x = v.x < 0.f ? m.x : r.x; o.y = v.y < 0.f ? m.y : r.y; return o;
}

template <int ACT  > struct EpiBf16 {
    static constexpr bool PERM = true, AFTER_DRAIN = false; static_assert(ACT == 0 || ACT == 1, "EpiBf16: ACT is 0 (none) or 1 (gelu_pk)");
    bf16_t* O; int ldc; const float* bias; int split_cols; size_t split_stride; float scale0;
    __device__ __forceinline__ void operator()(const f32x4 (&acc)[2][2][4][2], const Unit& u, int wr, int wc, int fr, int fq) const {
        const int row0 = u.pm * BM + wr * 64 + fr; int colt = u.pn * BM; bf16_t* base = O;
        float sc = 1.f; if (split_cols) { const int t = colt / split_cols; base += (size_t)t * split_stride; colt -= t * split_cols; if (t == 0) sc = scale0; }
        const int col0 = colt + wc * 32 + 8 * fq, bcol0 = u.pn * BM + wc * 32 + 8 * fq;
        f32x4 bv[2][2];
#pragma unroll
        for (int bj = 0; bj < 2; ++bj)
#pragma unroll
            for (int n = 0; n < 2; ++n) bv[bj][n] = bias ? *(const f32x4*)(bias + bcol0 + bj * HALF + 4 * n) : (f32x4){0.f, 0.f, 0.f, 0.f};
#pragma unroll
        for (int ai = 0; ai < 2; ++ai)
#pragma unroll
            for (int m = 0; m < 4; ++m) { bf16_t* rowp = base + (size_t)(row0 + ai * HALF + m * 16) * ldc + col0;
#pragma unroll
                for (int bj = 0; bj < 2; ++bj) { f32x4 v0 = acc[ai][bj][m][0] + bv[bj][0], v1 = acc[ai][bj][m][1] + bv[bj][1];
                    if (ACT == 1) { f32x2 a = gelu_pk((f32x2){v0[0], v0[1]}), b = gelu_pk((f32x2){v0[2], v0[3]}), c = gelu_pk((f32x2){v1[0], v1[1]}), d = gelu_pk((f32x2){v1[2], v1[3]});
                        v0 = (f32x4){a.x, a.y, b.x, b.y}; v1 = (f32x4){c.x, c.y, d.x, d.y}; }
                    v0 = v0 * sc; v1 = v1 * sc; u32x4 w; w.x = cvt_pk_bf16(v0[0], v0[1]); w.y = cvt_pk_bf16(v0[2], v0[3]); w.z = cvt_pk_bf16(v1[0], v1[1]); w.w = cvt_pk_bf16(v1[2], v1[3]);
                    *(u32x4*)(rowp + bj * HALF) = w; } }
    }
};
struct EpiF32 {
    static constexpr bool PERM = false, AFTER_DRAIN = false;
    float* C; int ldc; const float* bias; int pm0; size_t ks_stride;
    __device__ __forceinline__ void operator()(const f32x4 (&acc)[2][2][4][2], const Unit& u, int wr, int wc, int fr, int fq) const {
        const int row0 = (u.pm - pm0) * BM + wr * 64 + fr, col0 = u.pn * BM + wc * 32 + 4 * fq; float* C = this->C + (size_t)u.ks * ks_stride;
        f32x4 bv[2][2];
#pragma unroll
        for (int bj = 0; bj < 2; ++bj)
#pragma unroll
            for (int n = 0; n < 2; ++n) bv[bj][n] = bias ? *(const f32x4*)(bias + col0 + bj * HALF + n * 16) : (f32x4){0.f, 0.f, 0.f, 0.f};
#pragma unroll
        for (int ai = 0; ai < 2; ++ai)
#pragma unroll
            for (int m = 0; m < 4; ++m) { float* rowp = C + (size_t)(row0 + ai * HALF + m * 16) * ldc + col0;
#pragma unroll
                for (int bj = 0; bj < 2; ++bj)
#pragma unroll
                    for (int n = 0; n < 2; ++n) *(f32x4*)(rowp + bj * HALF + n * 16) = acc[ai][bj][m][n] + bv[bj][n]; }
    }
};
__device__ __forceinline__ float dpp_shr1(float old, float src) { return __builtin_bit_cast(float, __builtin_amdgcn_update_dpp(__builtin_bit_cast(int, old), __builtin_bit_cast(int, src), 0x111, 0xf, 0xf, false)); }
__device__ __forceinline__ float dpp_shr2(float old, float src) { return __builtin_bit_cast(float, __builtin_amdgcn_update_dpp(__builtin_bit_cast(int, old), __builtin_bit_cast(int, src), 0x112, 0xf, 0xf, false)); }
__device__ __forceinline__ float dpp_ror1(float src) { return __builtin_bit_cast(float, __builtin_amdgcn_update_dpp(0, __builtin_bit_cast(int, src), 0x121, 0xf, 0xf, false)); }
__device__ __forceinline__ float dpp_ror2(float src) { return __builtin_bit_cast(float, __builtin_amdgcn_update_dpp(0, __builtin_bit_cast(int, src), 0x122, 0xf, 0xf, false)); }
__device__ __forceinline__ float gelu_tanh(float x) {
    const float t = x * x, inner = x * (2.302208198f + 0.102943240f * t);
    return x * __builtin_amdgcn_rcpf(1.0f + __builtin_amdgcn_exp2f(-inner));
}
__device__ __forceinline__ f32x4 bf4_to_f4(const bf16_t* p) { const unsigned long long w = *(const unsigned long long*)p;
    return (f32x4){__builtin_bit_cast(float, (unsigned)(w << 16)), __builtin_bit_cast(float, (unsigned)w & 0xffff0000u), __builtin_bit_cast(float, (unsigned)(w >> 32) << 16), __builtin_bit_cast(float, (unsigned)(w >> 32) & 0xffff0000u)}; }

struct EpiConvGeglu {
    static constexpr bool PERM = true, AFTER_DRAIN = false;
    bf16_t* HB;
    const bf16_t* UB;
    const float* state;
    const float* wcv;
    const float* bcv;
    float* out_p;
    float* out_s;
    __device__ __forceinline__ void operator()(const f32x4 (&acc)[2][2][4][2], const Unit& u, int wr, int wc, int fr, int fq) const {
        const int cgb = u.pn * 128 + wc * 32 + 8 * fq;
        const int npb = u.pn * 256 + wc * 32 + 8 * fq;
#pragma unroll
        for (int n = 0; n < 2; ++n) {
            const int cg = cgb + 4 * n;
            const f32x4 w0g = *(const f32x4*)(wcv + cg), w1g = *(const f32x4*)(wcv + 6144 + cg), w2g = *(const f32x4*)(wcv + 12288 + cg), bg = *(const f32x4*)(bcv + cg);
            const f32x4 w0v = *(const f32x4*)(wcv + 3072 + cg), w1v = *(const f32x4*)(wcv + 6144 + 3072 + cg), w2v = *(const f32x4*)(wcv + 12288 + 3072 + cg), bv = *(const f32x4*)(bcv + 3072 + cg);
            f32x4 c1gA[2], c2gA[2], c1vA[2], c2vA[2];
#pragma unroll
            for (int ai = 0; ai < 2; ++ai) {
                const int r0 = u.pm * BM + ai * HALF + wr * 64;
                if (r0 >= 16384) { const float* st = state + (size_t)((r0 - 16384) >> 6) * 2 * 6144;
                    c2gA[ai] = *(const f32x4*)(st + cg); c1gA[ai] = *(const f32x4*)(st + 6144 + cg); c2vA[ai] = *(const f32x4*)(st + 3072 + cg); c1vA[ai] = *(const f32x4*)(st + 6144 + 3072 + cg); }
                else if ((r0 & 2047) == 0) { c1gA[ai] = c2gA[ai] = c1vA[ai] = c2vA[ai] = (f32x4){0.f, 0.f, 0.f, 0.f}; }
                else { const bf16_t* ub = UB + (size_t)(2 * (r0 >> 6)) * 6144 + npb + 4 * n;
                    c2gA[ai] = bf4_to_f4(ub); c1gA[ai] = bf4_to_f4(ub + 6144); c2vA[ai] = bf4_to_f4(ub + 128); c1vA[ai] = bf4_to_f4(ub + 6144 + 128); }
            }
#pragma unroll
            for (int ai = 0; ai < 2; ++ai) {
                const int r0 = u.pm * BM + ai * HALF + wr * 64;
                const f32x4 c1g = c1gA[ai], c2g = c2gA[ai], c1v = c1vA[ai], c2v = c2vA[ai];
#pragma unroll
                for (int m = 0; m < 4; ++m) {
                    const f32x4 xg = acc[ai][0][m][n], xv = acc[ai][1][m][n];
                    f32x4 o1g, o2g, o1v, o2v;
                    if (m == 0) { o1g = c1g; o1v = c1v; o2g = (fr == 0) ? c2g : c1g; o2v = (fr == 0) ? c2v : c1v; }
                    else { const f32x4 pg = acc[ai][0][m > 0 ? m - 1 : 0][n], pv = acc[ai][1][m > 0 ? m - 1 : 0][n];
#pragma unroll
                        for (int e = 0; e < 4; ++e) { o1g[e] = dpp_ror1(pg[e]); o2g[e] = dpp_ror2(pg[e]); o1v[e] = dpp_ror1(pv[e]); o2v[e] = dpp_ror2(pv[e]); } }
                    float res[4];
#pragma unroll
                    for (int e = 0; e < 4; ++e) {
                        const float g1 = dpp_shr1(o1g[e], xg[e]), g2 = dpp_shr2(o2g[e], xg[e]);
                        const float v1 = dpp_shr1(o1v[e], xv[e]), v2 = dpp_shr2(o2v[e], xv[e]);
                        const float cgv = bg[e] + w0g[e] * g2 + w1g[e] * g1 + w2g[e] * xg[e];
                        const float cvv = bv[e] + w0v[e] * v2 + w1v[e] * v1 + w2v[e] * xv[e];
                        res[e] = gelu_tanh(cgv) * cvv;
                    }
                    typedef unsigned u32x2v __attribute__((ext_vector_type(2)));
                    u32x2v w; w.x = cvt_pk_bf16(res[0], res[1]); w.y = cvt_pk_bf16(res[2], res[3]);
                    *(u32x2v*)(HB + (size_t)(r0 + 16 * m + fr) * 3072 + cg) = w;
                }
                const bool smp = r0 >= 16384;
                if ((smp || (((r0 + 64) & 2047) == 0)) && fr >= 14) {
                    float* o = (smp ? out_s + (size_t)((r0 - 16384) >> 6) * 2 * 6144 : out_p + (size_t)(r0 >> 11) * 2 * 6144) + (fr - 14) * 6144;
                    *(f32x4*)(o + cg) = acc[ai][0][3][n]; *(f32x4*)(o + 3072 + cg) = acc[ai][1][3][n];
                }
            }
        }
    }
};
template <class Epi, class Sched, bool ALIGN_EPI = false, bool SP2 = false>
__device__ __forceinline__ void gemm_phase(PG8_LAS unsigned char* lds, const Gemm g, const Sched& S, const Epi& E) {
    const int tid = threadIdx.x, wid = __builtin_amdgcn_readfirstlane(tid >> 6), lane = tid & 63, wr = wid >> 2, wc = wid & 3, fr = lane & 15, fq = lane >> 4;
    const int K = g.ld, nt = g.K / BK;
    unsigned voffA[2], voffB[2];
#pragma unroll
    for (int i = 0; i < 2; ++i) { int R, C; stage_rc(tid * 16 + i * 8192, R, C); const int Rb = Epi::PERM ? ((R & ~31) + perm32(R & 31)) : R;
        voffA[i] = (unsigned)(R * K + C) * 2u; voffB[i] = (unsigned)(Rb * K + C) * 2u; }
    const size_t kstep = (size_t)(BK * 2);
    const size_t hstep = (size_t)HALF * K * 2;
    const size_t tstep = 2 * hstep;
    const unsigned ldsw = (unsigned)wid * 1024u;
    const int aoff = lds_byte(wr * 64 + fr, fq * 8), boff = lds_byte(wc * 32 + fr, fq * 8);
#define PG8_SA(b, h) (((b) * 2 + (h)) * HTB)
#define PG8_SB(b, h) ((4 + (b) * 2 + (h)) * HTB)
#define PG8_STAGE(bufoff, gbase, voff) do { _Pragma("unroll") for (int _i = 0; _i < 2; ++_i) \
        __builtin_amdgcn_global_load_lds((const unsigned*)((const char*)(gbase) + (voff)[_i]), (PG8_LAS unsigned*)(lds + (bufoff) + ldsw + _i * 8192), 16, 0, 0); } while (0)
#define PG8_LDA(dst, b, h) do { _Pragma("unroll") for (int m = 0; m < 4; ++m) _Pragma("unroll") for (int k = 0; k < 2; ++k) dst[m][k] = *(const PG8_LAS bf16x8*)(lds + PG8_SA(b, h) + aoff + m * 2048 + k * 1024); } while (0)
#define PG8_LDB(dst, b, h) do { _Pragma("unroll") for (int n = 0; n < 2; ++n) _Pragma("unroll") for (int k = 0; k < 2; ++k) dst[n][k] = *(const PG8_LAS bf16x8*)(lds + PG8_SB(b, h) + boff + n * 2048 + k * 1024); } while (0)
#define PG8_MMA(ai, bj, At, Bt) do { __builtin_amdgcn_s_setprio(1); _Pragma("unroll") for (int m = 0; m < 4; ++m) _Pragma("unroll") for (int n = 0; n < 2; ++n) _Pragma("unroll") for (int k = 0; k < 2; ++k) \
        acc[ai][bj][m][n] = __builtin_amdgcn_mfma_f32_16x16x32_bf16(Bt[n][k], At[m][k], acc[ai][bj][m][n], 0, 0, 0); __builtin_amdgcn_s_setprio(0); } while (0)
#define PG8_WAIT_V(n) asm volatile("s_waitcnt vmcnt(" #n ")" ::: "memory")
#define PG8_WAIT_L(n) asm volatile("s_waitcnt lgkmcnt(" #n ")" ::: "memory")
#define PG8_BAR __builtin_amdgcn_s_barrier()
#define PG8_SCHED __builtin_amdgcn_sched_barrier(0)
    Unit cur, nxt; int ui = 0;
    if (!S.next(0, cur)) return;
    f32x4 acc[2][2][4][2];
#pragma unroll
    for (int a = 0; a < 2; ++a)
#pragma unroll
        for (int b = 0; b < 2; ++b)
#pragma unroll
            for (int m = 0; m < 4; ++m)
#pragma unroll
                for (int n = 0; n < 2; ++n) acc[a][b][m][n] = (f32x4){0.f, 0.f, 0.f, 0.f};
    bf16x8 At[4][2], B0[2][2], B1[2][2];
    const char* cA = (const char*)g.A + (size_t)cur.pm * tstep + (size_t)cur.k0 * 2; const char* cB = (const char*)g.Bt + (size_t)cur.pn * tstep + (size_t)cur.k0 * 2;
    S.a_ready(cur);
    if constexpr (SP2) {
        PG8_STAGE(PG8_SB(0, 0), cB, voffB); PG8_STAGE(PG8_SB(0, 1), cB + hstep, voffB); PG8_STAGE(PG8_SA(0, 0), cA, voffA); PG8_STAGE(PG8_SA(0, 1), cA + hstep, voffA);
        if (wr == 1) PG8_BAR;
        PG8_WAIT_V(2); PG8_BAR;
        PG8_STAGE(PG8_SB(1, 0), cB + kstep, voffB); PG8_STAGE(PG8_SA(1, 0), cA + kstep, voffA); PG8_STAGE(PG8_SB(1, 1), cB + hstep + kstep, voffB);
        PG8_WAIT_V(6); PG8_BAR;
    } else {
        PG8_STAGE(PG8_SB(0, 0), cB, voffB); PG8_STAGE(PG8_SA(0, 0), cA, voffA); PG8_STAGE(PG8_SB(0, 1), cB + hstep, voffB); PG8_STAGE(PG8_SA(0, 1), cA + hstep, voffA);
        if (wr == 1) PG8_BAR;
        PG8_WAIT_V(4); PG8_BAR;
        PG8_STAGE(PG8_SB(1, 0), cB + kstep, voffB); PG8_STAGE(PG8_SA(1, 0), cA + kstep, voffA); PG8_STAGE(PG8_SB(1, 1), cB + hstep + kstep, voffB);
        PG8_WAIT_V(6); PG8_BAR;
    }
    for (;;) {
        const bool has_next = S.next(ui + 1, nxt);
        const char* nA = has_next ? (const char*)g.A + (size_t)nxt.pm * tstep + (size_t)nxt.k0 * 2 : cA; const char* nB = has_next ? (const char*)g.Bt + (size_t)nxt.pn * tstep + (size_t)nxt.k0 * 2 : cB;
        for (int t = 0; t < nt; t += 2) {
            const bool last = (t == nt - 2);
            const char* a1 = cA + (size_t)(t + 1) * kstep;
            const char* a2 = last ? nA : cA + (size_t)(t + 2) * kstep; const char* b2 = last ? nB : cB + (size_t)(t + 2) * kstep;
            const char* a3 = a2 + kstep; const char* b3 = b2 + kstep;
            if (last && has_next) S.a_ready(nxt);
            if constexpr (SP2) {
            PG8_LDB(B0, 0, 0); PG8_LDB(B1, 0, 1); PG8_SCHED; PG8_LDA(At, 0, 0); PG8_STAGE(PG8_SA(1, 1), a1 + hstep, voffA);
            PG8_WAIT_V(8); PG8_WAIT_L(0); PG8_BAR; PG8_MMA(0, 0, At, B0); PG8_MMA(0, 1, At, B1); PG8_BAR; PG8_SCHED;
            PG8_LDA(At, 0, 1); PG8_STAGE(PG8_SB(0, 0), b2, voffB); PG8_STAGE(PG8_SB(0, 1), b2 + hstep, voffB); PG8_STAGE(PG8_SA(0, 0), a2, voffA);
            PG8_WAIT_V(8); PG8_WAIT_L(0); PG8_BAR; PG8_MMA(1, 0, At, B0); PG8_MMA(1, 1, At, B1); PG8_BAR; PG8_SCHED;
            PG8_LDB(B0, 1, 0); PG8_LDB(B1, 1, 1); PG8_SCHED; PG8_LDA(At, 1, 0); PG8_STAGE(PG8_SA(0, 1), a2 + hstep, voffA);
            PG8_WAIT_V(8); PG8_WAIT_L(0); PG8_BAR; PG8_MMA(0, 0, At, B0); PG8_MMA(0, 1, At, B1); PG8_BAR; PG8_SCHED;
            PG8_LDA(At, 1, 1); PG8_STAGE(PG8_SB(1, 0), b3, voffB); PG8_STAGE(PG8_SB(1, 1), b3 + hstep, voffB); PG8_STAGE(PG8_SA(1, 0), a3, voffA);
            PG8_WAIT_V(8); PG8_WAIT_L(0); PG8_BAR; PG8_MMA(1, 0, At, B0); PG8_MMA(1, 1, At, B1); PG8_BAR; PG8_SCHED;
            } else {
            PG8_LDB(B0, 0, 0); PG8_SCHED; PG8_LDA(At, 0, 0); PG8_STAGE(PG8_SA(1, 1), a1 + hstep, voffA);
            PG8_WAIT_L(8); PG8_BAR; PG8_WAIT_L(0); PG8_MMA(0, 0, At, B0); PG8_BAR; PG8_SCHED;
            PG8_LDB(B1, 0, 1); PG8_STAGE(PG8_SB(0, 0), b2, voffB);
            PG8_BAR; PG8_WAIT_L(0); PG8_MMA(0, 1, At, B1); PG8_BAR;
            PG8_LDA(At, 0, 1); PG8_STAGE(PG8_SA(0, 0), a2, voffA);
            PG8_BAR; PG8_WAIT_L(0); PG8_MMA(1, 0, At, B0); PG8_BAR; PG8_SCHED;
            PG8_STAGE(PG8_SB(0, 1), b2 + hstep, voffB);
            PG8_WAIT_V(6); PG8_BAR; PG8_MMA(1, 1, At, B1); PG8_BAR;
            PG8_LDB(B0, 1, 0); PG8_SCHED; PG8_LDA(At, 1, 0); PG8_STAGE(PG8_SA(0, 1), a2 + hstep, voffA);
            PG8_WAIT_L(8); PG8_BAR; PG8_WAIT_L(0); PG8_MMA(0, 0, At, B0); PG8_BAR; PG8_SCHED;
            PG8_LDB(B1, 1, 1); PG8_STAGE(PG8_SB(1, 0), b3, voffB);
            PG8_BAR; PG8_WAIT_L(0); PG8_MMA(0, 1, At, B1); PG8_BAR;
            PG8_LDA(At, 1, 1); PG8_STAGE(PG8_SA(1, 0), a3, voffA);
            PG8_BAR; PG8_WAIT_L(0); PG8_MMA(1, 0, At, B0); PG8_BAR; PG8_SCHED;
            PG8_STAGE(PG8_SB(1, 1), b3 + hstep, voffB);
            PG8_WAIT_V(6); PG8_BAR; PG8_MMA(1, 1, At, B1); PG8_BAR;
            }
        }
        if constexpr (ALIGN_EPI) { if (wr == 0) PG8_BAR; }
        if constexpr (!Epi::AFTER_DRAIN) { E(acc, cur, wr, wc, fr, fq); S.done(cur); }
        if (!has_next) break;
#pragma unroll
        for (int a = 0; a < 2; ++a)
#pragma unroll
            for (int b = 0; b < 2; ++b)
#pragma unroll
                for (int m = 0; m < 4; ++m)
#pragma unroll
                    for (int n = 0; n < 2; ++n) acc[a][b][m][n] = (f32x4){0.f, 0.f, 0.f, 0.f};
        cur = nxt; cA = nA; cB = nB; ++ui;
        if constexpr (ALIGN_EPI) { if (wr == 1) PG8_BAR; }
    }
    PG8_WAIT_V(0);
    if constexpr (!ALIGN_EPI) { if (wr == 0) PG8_BAR; }
    PG8_BAR;
    if constexpr (Epi::AFTER_DRAIN) { E.fused(acc, cur, wr, wc, fr, fq, lds, wid, lane); S.done(cur); }
#undef PG8_SA
#undef PG8_SB
#undef PG8_STAGE
#undef PG8_LDA
#undef PG8_LDB
#undef PG8_MMA
#undef PG8_WAIT_V
#undef PG8_WAIT_L
#undef PG8_BAR
#undef PG8_SCHED
}
}

constexpr int D = 1024, NB = 8, SEQ = 2048, NS = 16, SSEQ = 64, MP = NB * SEQ, M = MP + NS * SSEQ;
constexpr int DA = 512, DB = 512, DIN = 2048, FF = 3072, FF2 = 6144;
constexpr float EPS = 1e-6f;
constexpr size_t O_Y = 0, O_HP = (size_t)M * D, O_CP = O_HP + NB * DA, O_FP = O_CP + NB * 3 * DA, O_HS = O_FP + NB * 2 * FF2, O_CS = O_HS + NS * DA, O_FS = O_CS + NS * 3 * DA, O_VS = O_FS + NS * 2 * FF2,
                 O_END = O_VS + (size_t)NS * SSEQ * DB;
constexpr size_t MiB = 1u << 20;
constexpr size_t WS_CTL = 0, CTL_ZERO_BYTES = 65536;
constexpr size_t WS_WIN = 2 * MiB, WS_WO = 6 * MiB, WS_WUP = 8 * MiB, WS_WDN = 20 * MiB, WS_XN = 26 * MiB, WS_Z = 60 * MiB, WS_MIX = 128 * MiB, WS_HB = 60 * MiB, WS_F = 162 * MiB,
                 WS_XNB = 230 * MiB, WS_UB = 231 * MiB, WS_AGG = 237 * MiB, WS_WRF = 238 * MiB, WS_END = 239 * MiB,
                 WS_ZP = 162 * MiB  , WS_YP = 162 * MiB  ,
                 WS_FP = 26 * MiB  , WS_UBP = 162 * MiB  ;
constexpr int LDS_BYTES = 147456;

#define GAS __attribute__((address_space(1)))
#define LAS __attribute__((address_space(3)))
typedef unsigned short bf16;
typedef float f32x4 __attribute__((ext_vector_type(4)));
typedef short bf16x8 __attribute__((ext_vector_type(8)));
typedef unsigned v4u __attribute__((ext_vector_type(4)));
typedef unsigned v2u __attribute__((ext_vector_type(2)));
#define LDS_WAIT() asm volatile("s_waitcnt lgkmcnt(0)" ::: "memory")

__device__ __forceinline__ unsigned f2bf(float f) { unsigned u = __builtin_bit_cast(unsigned, f); return (u + 0x7fffu + ((u >> 16) & 1u)) >> 16; }
__device__ __forceinline__ unsigned pk2(float lo, float hi) { return f2bf(lo) | (f2bf(hi) << 16); }
__device__ __forceinline__ float bf2f(bf16 b) { return __builtin_bit_cast(float, (unsigned)b << 16); }
__device__ __forceinline__ float wave_sum(float v) {
#pragma unroll
    for (int o = 1; o < 64; o <<= 1) v += __shfl_xor(v, o);
    return v;
}
__device__ __forceinline__ float sigmoidf_(float z) { return __builtin_amdgcn_rcpf(1.0f + __builtin_amdgcn_exp2f(-1.4426950408889634f * z)); }

__device__ __forceinline__ void p0_transpose_item(const float* W, int K, int N, bf16* WT, bool up_perm, LAS float* scr, int item, int lane) {
    const int nblk = N / 32, kb = item / nblk, nb = item % nblk, k0 = 64 * kb, n0 = 32 * nb;
#pragma unroll 8
    for (int i = 0; i < 32; ++i) { const int kk = 2 * i + (lane >> 5); scr[kk * 33 + (lane & 31)] = W[(size_t)(k0 + kk) * N + n0 + (lane & 31)]; }
    LDS_WAIT(); asm volatile("" ::: "memory");
    int rb = n0; if (up_perm) { const int hi = n0 >= FF ? 1 : 0, cc = n0 - hi * FF; rb = (cc >> 7) * 256 + hi * 128 + (cc & 127); }
    const int c = lane & 7;
#pragma unroll
    for (int j = 0; j < 4; ++j) { const int n = (lane >> 3) + 8 * j; const LAS float* s = scr + (8 * c) * 33 + n;
        v4u o; o.x = pk2(s[0 * 33], s[1 * 33]); o.y = pk2(s[2 * 33], s[3 * 33]); o.z = pk2(s[4 * 33], s[5 * 33]); o.w = pk2(s[6 * 33], s[7 * 33]);
        *(v4u*)(WT + (size_t)(rb + n) * K + k0 + 8 * c) = o; }
    LDS_WAIT(); asm volatile("" ::: "memory");
}

struct P {
    const float *xp, *xs, *st_h, *st_conv, *st_ffn, *g_pre1, *w_in, *w_conv_a, *b_conv_a, *w_r, *b_r, *w_i, *b_i, *lam, *g_out_a, *g_v, *b_v, *w_s, *b_s, *g_out_b, *w_o, *g_post1, *g_pre2, *w_up,
                *w_conv_f, *b_conv_f, *w_down, *g_post2;
    float* out; unsigned char* ws;
};
__device__ __forceinline__ const float* xrow(const P& p, int m) { return m < MP ? p.xp + (size_t)m * D : p.xs + (size_t)(m - MP) * D; }

__device__ __forceinline__ void row_pre1(const P& p, int m, int lane) {
    const f32x4* xr = (const f32x4*)xrow(p, m) + lane; const f32x4* gr = (const f32x4*)p.g_pre1 + lane;
    f32x4 v[4]; float s = 0.f;
#pragma unroll
    for (int j = 0; j < 4; ++j) { v[j] = xr[64 * j]; s += (v[j].x * v[j].x + v[j].y * v[j].y) + (v[j].z * v[j].z + v[j].w * v[j].w); }
    const float rs = 1.0f / sqrtf(wave_sum(s) * (1.f / D) + EPS);
    unsigned long long* o8 = (unsigned long long*)((bf16*)(p.ws + WS_XN) + (size_t)m * D) + lane;
#pragma unroll
    for (int j = 0; j < 4; ++j) { const f32x4 g = gr[64 * j]; o8[64 * j] = (unsigned long long)pk2(v[j].x * rs * g.x, v[j].y * rs * g.y) | ((unsigned long long)pk2(v[j].z * rs * g.z, v[j].w * rs * g.w) << 32); }
}
__device__ __forceinline__ void row_post1(const P& p, int m, int lane) {
    const f32x4* xr = (const f32x4*)xrow(p, m) + lane; f32x4* yr = (f32x4*)(p.out + O_Y + (size_t)m * D) + lane;
    const f32x4* g1 = (const f32x4*)p.g_post1 + lane; const f32x4* g2 = (const f32x4*)p.g_pre2 + lane;
    f32x4 y[4]; float s = 0.f;
#pragma unroll
    for (int j = 0; j < 4; ++j) {
        if (m < MP) y[j] = yr[64 * j];
        else { const f32x4* yp = (const f32x4*)((const float*)(p.ws + WS_YP) + (size_t)(m - MP) * D) + lane + 64 * j; y[j] = (yp[0] + yp[262144]) + (yp[2 * 262144] + yp[3 * 262144]); }
        s += (y[j].x * y[j].x + y[j].y * y[j].y) + (y[j].z * y[j].z + y[j].w * y[j].w); }
    const float rs = 1.0f / sqrtf(wave_sum(s) * (1.f / D) + EPS); float s2 = 0.f;
#pragma unroll
    for (int j = 0; j < 4; ++j) { y[j] = xr[64 * j] + y[j] * rs * g1[64 * j]; yr[64 * j] = y[j]; s2 += (y[j].x * y[j].x + y[j].y * y[j].y) + (y[j].z * y[j].z + y[j].w * y[j].w); }
    const float rs2 = 1.0f / sqrtf(wave_sum(s2) * (1.f / D) + EPS);
    unsigned long long* o8 = (unsigned long long*)((bf16*)(p.ws + WS_XN) + (size_t)m * D) + lane;
    unsigned long long* b8 = nullptr;
    if (m < MP - 64 && (m & 63) >= 62) b8 = (unsigned long long*)((bf16*)(p.ws + WS_XNB) + (size_t)(2 * ((m >> 6) + 1) + (m & 63) - 62) * D) + lane;
#pragma unroll
    for (int j = 0; j < 4; ++j) { const f32x4 g = g2[64 * j]; const unsigned long long w = (unsigned long long)pk2(y[j].x * rs2 * g.x, y[j].y * rs2 * g.y) | ((unsigned long long)pk2(y[j].z * rs2 * g.z, y[j].w * rs2 * g.w) << 32);
        o8[64 * j] = w; if (b8) b8[64 * j] = w; }
}
__device__ __forceinline__ void row_post2(const P& p, int m, int lane) {
    const f32x4* fr = (const f32x4*)((const float*)(p.ws + WS_F) + (size_t)m * D) + lane; f32x4* yr = (f32x4*)(p.out + O_Y + (size_t)m * D) + lane;
    const f32x4* g1 = (const f32x4*)p.g_post2 + lane;
    f32x4 y[4]; float s = 0.f;
#pragma unroll
    for (int j = 0; j < 4; ++j) {
        if (m < MP) y[j] = fr[64 * j];
        else { const f32x4* fp = (const f32x4*)((const float*)(p.ws + WS_FP) + (size_t)(m - MP) * D) + lane + 64 * j;
            y[j] = ((fp[0] + fp[262144]) + (fp[2 * 262144] + fp[3 * 262144])) + ((fp[4 * 262144] + fp[5 * 262144]) + (fp[6 * 262144] + fp[7 * 262144])); }
        s += (y[j].x * y[j].x + y[j].y * y[j].y) + (y[j].z * y[j].z + y[j].w * y[j].w); }
    const float rs = 1.0f / sqrtf(wave_sum(s) * (1.f / D) + EPS);
#pragma unroll
    for (int j = 0; j < 4; ++j) yr[64 * j] = yr[64 * j] + y[j] * rs * g1[64 * j];
}

constexpr int MA_WL = 10752, MA_YS = 8 * MA_WL;
template <bool FINAL>
__device__ __forceinline__ void mixer_a_item(const P& p, LAS unsigned char* lds, int q, int wave, int lane) {
    const bool smp = q >= 256; const int b = q >> 5, cc = q & 31, sidx = q - 256;
    const int row0 = smp ? MP + sidx * SSEQ : b * SEQ + cc * 64;
    const int c = wave * 64 + lane;
    const bf16* Z = (const bf16*)(p.ws + WS_Z);
    float* AGG = (float*)(p.ws + WS_AGG);
    LAS unsigned char* wl = lds + wave * MA_WL;
    LAS bf16* XC = (LAS bf16*)wl;
    LAS float* RB = (LAS float*)(wl + 2560);
    LAS float* IB = (LAS float*)(wl + 2560 + 4096);
    LAS float* YS = (LAS float*)(lds + MA_YS);
    bf16x8 BR[2][4], BI[2][4];
    { const bf16x8* wf = (const bf16x8*)(p.ws + WS_WRF) + (size_t)wave * 8 * 64 + lane;
#pragma unroll
      for (int ks = 0; ks < 2; ++ks)
#pragma unroll
        for (int nt = 0; nt < 4; ++nt) { BR[ks][nt] = wf[(ks * 4 + nt) * 64]; BI[ks][nt] = wf[(size_t)8 * 8 * 64 + (ks * 4 + nt) * 64]; } }
    const float cw0 = p.w_conv_a[c], cw1 = p.w_conv_a[DA + c], cw2 = p.w_conv_a[2 * DA + c], cw3 = p.w_conv_a[3 * DA + c], cb = p.b_conv_a[c];
    const float br = p.b_r[c], bi = p.b_i[c];
    const float m8sp = -8.0f * log1pf(expf(-p.lam[c]));
    float xm3, xm2, xm1, h;
    if (smp) { const float* sc = p.st_conv + (size_t)sidx * 3 * DA; xm3 = sc[c]; xm2 = sc[DA + c]; xm1 = sc[2 * DA + c]; h = FINAL ? p.st_h[(size_t)sidx * DA + c] : 0.f; }
    else if (cc == 0) { xm3 = xm2 = xm1 = 0.f; h = 0.f; }
    else { const bf16* zp = Z + (size_t)(row0 - 3) * DIN + DA + c; xm3 = bf2f(zp[0]); xm2 = bf2f(zp[DIN]); xm1 = bf2f(zp[2 * DIN]); h = 0.f;
        if (FINAL) { const float* ag = AGG + (size_t)(b * 32) * 2 * DA + c; for (int k = 0; k < cc; ++k) h = ag[(size_t)k * 2 * DA] * h + ag[(size_t)k * 2 * DA + DA]; } }
    const bool first = !smp && cc == 0;
    float slog = 0.f;
    bf16* MIX = (bf16*)(p.ws + WS_MIX);
    const f32x4 ga = *(const f32x4*)(p.g_out_a + lane * 8), gb = *(const f32x4*)(p.g_out_a + lane * 8 + 4);
#pragma unroll 1
    for (int sc = 0; sc < 4; ++sc) {
        float xc[16];
        const bf16* zr = Z + (size_t)(row0 + sc * 16) * DIN + c;
#pragma unroll
        for (int tt = 0; tt < 16; ++tt) { const float xin = bf2f(zr[(size_t)tt * DIN + DA]);
            const float v = cb + cw0 * xm3 + cw1 * xm2 + cw2 * xm1 + cw3 * xin; xm3 = xm2; xm2 = xm1; xm1 = xin; xc[tt] = v; XC[tt * 72 + lane] = (bf16)f2bf(v); }
        LDS_WAIT();
        const bf16x8 a0 = *(const LAS bf16x8*)(XC + (lane & 15) * 72 + (lane >> 4) * 8), a1 = *(const LAS bf16x8*)(XC + (lane & 15) * 72 + 32 + (lane >> 4) * 8);
#pragma unroll
        for (int nt = 0; nt < 4; ++nt) { pg8::f32x4 ar = {0.f, 0.f, 0.f, 0.f}, ai = {0.f, 0.f, 0.f, 0.f};
            ar = __builtin_amdgcn_mfma_f32_16x16x32_bf16(a0, BR[0][nt], ar, 0, 0, 0); ar = __builtin_amdgcn_mfma_f32_16x16x32_bf16(a1, BR[1][nt], ar, 0, 0, 0);
            ai = __builtin_amdgcn_mfma_f32_16x16x32_bf16(a0, BI[0][nt], ai, 0, 0, 0); ai = __builtin_amdgcn_mfma_f32_16x16x32_bf16(a1, BI[1][nt], ai, 0, 0, 0);
#pragma unroll
            for (int r = 0; r < 4; ++r) { RB[((lane >> 4) * 4 + r) * 64 + nt * 16 + (lane & 15)] = ar[r]; IB[((lane >> 4) * 4 + r) * 64 + nt * 16 + (lane & 15)] = ai[r]; } }
        LDS_WAIT();
        if (FINAL && sc > 0) __syncthreads();
#pragma unroll
        for (int tt = 0; tt < 16; ++tt) {
            const float rg = sigmoidf_(RB[tt * 64 + lane] + br), ig = sigmoidf_(IB[tt * 64 + lane] + bi);
            const float la = m8sp * rg; const float a = __builtin_amdgcn_exp2f(1.4426950408889634f * la);
            float mult = sqrtf(-expm1f(2.0f * la)); if (first && sc == 0 && tt == 0) mult = 1.0f;
            h = a * h + mult * (ig * xc[tt]); slog += la;
            if (FINAL) { const float g = bf2f(zr[(size_t)tt * DIN]); YS[tt * DA + c] = h * pg8::gelu_tanh(g); }
        }
        LDS_WAIT();
        if (FINAL) {
            __syncthreads();
#pragma unroll
            for (int tj = 0; tj < 2; ++tj) { const int t = wave * 2 + tj;
                const f32x4 va = *(const LAS f32x4*)(YS + t * DA + lane * 8), vb = *(const LAS f32x4*)(YS + t * DA + lane * 8 + 4);
                const float ss = wave_sum((va.x * va.x + va.y * va.y) + (va.z * va.z + va.w * va.w) + (vb.x * vb.x + vb.y * vb.y) + (vb.z * vb.z + vb.w * vb.w));
                const float rs = 1.0f / sqrtf(ss * (1.f / DA) + EPS);
                v4u o; o.x = pk2(va.x * rs * ga.x, va.y * rs * ga.y); o.y = pk2(va.z * rs * ga.z, va.w * rs * ga.w); o.z = pk2(vb.x * rs * gb.x, vb.y * rs * gb.y); o.w = pk2(vb.z * rs * gb.z, vb.w * rs * gb.w);
                *(v4u*)(MIX + (size_t)(row0 + sc * 16 + t) * D + lane * 8) = o; }
            LDS_WAIT();
        }
    }
    if (!FINAL) { AGG[(size_t)q * 2 * DA + c] = expf(slog); AGG[(size_t)q * 2 * DA + DA + c] = h; return; }
    if (smp || cc == 31) {
        float* oh = smp ? p.out + O_HS + (size_t)sidx * DA : p.out + O_HP + (size_t)b * DA; oh[c] = h;
        float* oc = smp ? p.out + O_CS + (size_t)sidx * 3 * DA : p.out + O_CP + (size_t)b * 3 * DA; oc[c] = xm3; oc[DA + c] = xm2; oc[2 * DA + c] = xm1;
    }
    __syncthreads();
}

constexpr int VP = 132;
__device__ __forceinline__ void mixer_b_item(const P& p, LAS unsigned char* lds, int k, int wave, int lane) {
    const bool smp = k >= 128; const int sidx = k - 128; const int L = smp ? 64 : 128; const int row0 = smp ? MP + sidx * SSEQ : k * 128;
    const bf16* Z = (const bf16*)(p.ws + WS_Z);
    LAS bf16* VNt = (LAS bf16*)lds;
    const int RW = L / 8;
    {
    float gv[8], bv[8];
#pragma unroll
    for (int e = 0; e < 8; ++e) { gv[e] = p.g_v[e * 64 + lane]; bv[e] = p.b_v[e * 64 + lane]; }
#pragma unroll 1
    for (int jj = 0; jj < RW; ++jj) { const int j = wave * RW + jj; const bf16* zr = Z + (size_t)(row0 + j) * DIN + 3 * DA;
        float v[8]; float s = 0.f;
#pragma unroll
        for (int e = 0; e < 8; ++e) { v[e] = bf2f(zr[e * 64 + lane]); s += v[e]; }
        const float mu = wave_sum(s) * (1.f / DB); float s2 = 0.f;
#pragma unroll
        for (int e = 0; e < 8; ++e) { v[e] -= mu; s2 += v[e] * v[e]; }
        const float rstd = 1.0f / sqrtf(wave_sum(s2) * (1.f / DB) + EPS);
#pragma unroll
        for (int e = 0; e < 8; ++e) { const float vn = v[e] * rstd * gv[e] + bv[e]; VNt[(e * 64 + lane) * VP + j] = (bf16)f2bf(vn);
            if (smp) p.out[O_VS + ((size_t)sidx * SSEQ + j) * DB + e * 64 + lane] = vn; }
    }
    }
    __syncthreads();
    if (wave * 16 < L) {
        const int i0 = wave * 16, nks = (smp || i0 < 64) ? 2 : 4;
        const int il = lane & 15, kg = lane >> 4; const int row = row0 + i0 + il;
        bf16* MIX = (bf16*)(p.ws + WS_MIX);
        float ss = 0.f, rs = 0.f;
#pragma unroll 1
        for (int pass = 0; pass < 2; ++pass) {
#pragma unroll 1
            for (int hh = 0; hh < 4; ++hh) {
                bf16x8 wf[4];
#pragma unroll
                for (int ks = 0; ks < 4; ++ks) { wf[ks] = (bf16x8){0, 0, 0, 0, 0, 0, 0, 0};
                    if (ks < nks) { const float* wp = p.w_s + ((size_t)hh * 128 + i0 + il) * 128 + ks * 32 + kg * 8; const f32x4 w0 = *(const f32x4*)wp, w1 = *(const f32x4*)(wp + 4);
                        wf[ks][0] = (short)f2bf(w0.x); wf[ks][1] = (short)f2bf(w0.y); wf[ks][2] = (short)f2bf(w0.z); wf[ks][3] = (short)f2bf(w0.w);
                        wf[ks][4] = (short)f2bf(w1.x); wf[ks][5] = (short)f2bf(w1.y); wf[ks][6] = (short)f2bf(w1.z); wf[ks][7] = (short)f2bf(w1.w); } }
                const float bs = p.b_s[hh * 128 + i0 + il];
#pragma unroll 2
                for (int dt = 0; dt < 8; ++dt) { pg8::f32x4 a = {0.f, 0.f, 0.f, 0.f};
#pragma unroll
                    for (int ks = 0; ks < 4; ++ks) if (ks < nks) { const LAS bf16* vp = VNt + (hh * 128 + dt * 16 + il) * VP + ks * 32 + kg * 8;
                        typedef short s16x4 __attribute__((ext_vector_type(4)));
                        const s16x4 lo = *(const LAS s16x4*)vp, hi = *(const LAS s16x4*)(vp + 4);
                        const bf16x8 af = {lo[0], lo[1], lo[2], lo[3], hi[0], hi[1], hi[2], hi[3]};
                        a = __builtin_amdgcn_mfma_f32_16x16x32_bf16(af, wf[ks], a, 0, 0, 0); }
                    const int d0 = hh * 128 + dt * 16 + kg * 4; const pg8::f32x4 u4 = pg8::bf4_to_f4(Z + (size_t)row * DIN + 2 * DA + d0);
                    const pg8::f32x4 yv = u4 * (a + bs);
                    if (pass == 0) ss += (yv[0] * yv[0] + yv[1] * yv[1]) + (yv[2] * yv[2] + yv[3] * yv[3]);
                    else { const f32x4 g = *(const f32x4*)(p.g_out_b + d0);
                        v2u o; o.x = pk2(yv[0] * rs * g.x, yv[1] * rs * g.y); o.y = pk2(yv[2] * rs * g.z, yv[3] * rs * g.w);
                        *(v2u*)(MIX + (size_t)row * D + DA + d0) = o; }
                }
            }
            if (pass == 0) { ss += __shfl_xor(ss, 16); ss += __shfl_xor(ss, 32); rs = 1.0f / sqrtf(ss * (1.f / DB) + EPS); }
        }
    }
    __syncthreads();
}


#define XB_TMO      128
#define XB_XCNT(j)  (256  + 64 * (j))
#define XB_XSUB(j)  (1280 + 64 * (j))
#define XB_XGEN(j)  (2304 + 64 * (j))
#define XB_TOP      3328
#define XB_TOPGEN   3392
#define XCD_BAR_WORDS 3456
#define XB_SPIN_CAP (1u << 18)

__device__ __forceinline__ unsigned xb_ld(unsigned* p)              { return __hip_atomic_load(p, __ATOMIC_RELAXED, __HIP_MEMORY_SCOPE_AGENT); }
__device__ __forceinline__ unsigned xb_add(unsigned* p, unsigned v) { return __hip_atomic_fetch_add(p, v, __ATOMIC_RELAXED, __HIP_MEMORY_SCOPE_AGENT); }
__device__ __forceinline__ unsigned xb_xcc_id() { return (unsigned)__builtin_amdgcn_s_getreg((3 << 11) | 20) & 0xFu; }
#define XB_SPIN(cond, bar) do { unsigned _sp = 0; while (cond) { __builtin_amdgcn_s_sleep(1); \
    if ((++_sp & 255u) == 0u) { if (xb_ld(&(bar)[XB_TMO])) break; if (_sp > XB_SPIN_CAP) { atomicAdd(&(bar)[XB_TMO], 1u); break; } } } } while (0)

struct XcdBarrier {
    unsigned* bar; unsigned x;
    volatile LAS unsigned* st;
};

__device__ __forceinline__ XcdBarrier xcd_barrier_post(unsigned* bar, volatile LAS unsigned* st) {
    XcdBarrier b; b.bar = bar; b.x = xb_xcc_id(); b.st = st;
    if (threadIdx.x == 0) (void)xb_add(&bar[XB_XCNT(b.x)], 1u);
    return b;
}
__device__ __forceinline__ void xcd_barrier_complete(unsigned* bar, unsigned x, unsigned& nloc, unsigned& nx) {
    const unsigned G = gridDim.x * gridDim.y * gridDim.z;
    unsigned sum, cnt, mine, sp = 0u;
    for (;;) {
        sum = 0u; cnt = 0u; mine = 0u;
#pragma unroll
        for (unsigned j = 0; j < 16; ++j) { const unsigned c = xb_ld(&bar[XB_XCNT(j)]); sum += c; cnt += (c > 0u) ? 1u : 0u; mine = (j == x) ? c : mine; }
        if (sum == G) break;
        __builtin_amdgcn_s_sleep(1);
        if ((++sp & 255u) == 0u) { if (xb_ld(&bar[XB_TMO])) break; if (sp > XB_SPIN_CAP) { atomicAdd(&bar[XB_TMO], 1u); break; } }
    }
    nloc = mine > 0u ? mine : 1u; nx = cnt > 0u ? cnt : 1u;
}

__device__ __forceinline__ void xcd_barrier(const XcdBarrier& b) {
    asm volatile("s_waitcnt vmcnt(0)" ::: "memory");
    __syncthreads();
    if (threadIdx.x == 0) {
        unsigned* bar = b.bar;
        __builtin_amdgcn_s_waitcnt(0);
        unsigned nloc = b.st[0], nx = b.st[1];
        if (nloc == 0u) { xcd_barrier_complete(bar, b.x, nloc, nx); b.st[0] = nloc; b.st[1] = nx; }
        const unsigned old = xb_add(&bar[XB_XSUB(b.x)], 1u);
        const unsigned gen = old / nloc;
        if (old + 1u == (gen + 1u) * nloc) {
            __builtin_amdgcn_fence(__ATOMIC_RELEASE, "agent");
            asm volatile("s_waitcnt vmcnt(0)" ::: "memory");
            const unsigned og = xb_add(&bar[XB_TOP], 1u);
            const unsigned tg = og / nx;
            if (og + 1u == (tg + 1u) * nx) xb_add(&bar[XB_TOPGEN], 1u);
            else XB_SPIN(xb_ld(&bar[XB_TOPGEN]) == tg, bar);
            __builtin_amdgcn_fence(__ATOMIC_ACQUIRE, "agent");
            xb_add(&bar[XB_XGEN(b.x)], 1u);
            asm volatile("s_waitcnt vmcnt(0)" ::: "memory");
        } else {
            XB_SPIN(xb_ld(&bar[XB_XGEN(b.x)]) == gen, bar);
            __builtin_amdgcn_fence(__ATOMIC_ACQUIRE, "agent");
            asm volatile("s_waitcnt vmcnt(0)" ::: "memory");
        }
    }
    __syncthreads();
}

struct Args { const float* in[28]; float* out; unsigned char* ws; int ph_lo, ph_hi; };
constexpr int NPH = 10;
__global__ void __launch_bounds__(512, 2) fwd(Args args) {
    extern __shared__ __attribute__((aligned(16))) unsigned char lds_raw[];
    LAS unsigned char* lds = (LAS unsigned char*)lds_raw;
    const int tid = threadIdx.x, lane = tid & 63, wave = __builtin_amdgcn_readfirstlane(tid >> 6);
    const int G = gridDim.x, bx = blockIdx.x;
    const int gw = bx * 8 + wave, NGW = G * 8;
    P p;
    p.xp = args.in[0]; p.xs = args.in[1]; p.st_h = args.in[2]; p.st_conv = args.in[3]; p.st_ffn = args.in[4]; p.g_pre1 = args.in[5]; p.w_in = args.in[6]; p.w_conv_a = args.in[7]; p.b_conv_a = args.in[8];
    p.w_r = args.in[9]; p.b_r = args.in[10]; p.w_i = args.in[11]; p.b_i = args.in[12]; p.lam = args.in[13]; p.g_out_a = args.in[14]; p.g_v = args.in[15]; p.b_v = args.in[16]; p.w_s = args.in[17]; p.b_s = args.in[18];
    p.g_out_b = args.in[19]; p.w_o = args.in[20]; p.g_post1 = args.in[21]; p.g_pre2 = args.in[22]; p.w_up = args.in[23]; p.w_conv_f = args.in[24]; p.b_conv_f = args.in[25]; p.w_down = args.in[26]; p.g_post2 = args.in[27];
    p.out = args.out; p.ws = args.ws;
    unsigned char* ws = args.ws;
    bf16 *Wt_in = (bf16*)(ws + WS_WIN), *Wt_o = (bf16*)(ws + WS_WO), *Wt_up = (bf16*)(ws + WS_WUP), *Wt_dn = (bf16*)(ws + WS_WDN);
    bf16 *XN = (bf16*)(ws + WS_XN), *Zb = (bf16*)(ws + WS_Z), *MIX = (bf16*)(ws + WS_MIX), *HB = (bf16*)(ws + WS_HB), *XNB = (bf16*)(ws + WS_XNB), *UB = (bf16*)(ws + WS_UB);
    float* Fb = (float*)(ws + WS_F);
    const int lo = args.ph_lo, hi = args.ph_hi;
    volatile LAS unsigned* MISC = (volatile LAS unsigned*)(lds + LDS_BYTES - 64);
    if (tid < 16) MISC[tid] = 0u;
    __syncthreads();
    XcdBarrier bar = xcd_barrier_post((unsigned*)(ws + WS_CTL) + 1024, MISC);
#ifndef PHASE_MASK
#define PHASE_MASK 0x3ff
#endif
#define IN(k) ((((PHASE_MASK) >> (k)) & 1) && lo <= (k) && (k) < hi)
#ifndef SYNC_REPS
#define SYNC_REPS 1
#endif
#ifndef MIX_REPS
#define MIX_REPS 1
#endif
#define SEAM(k) do { if (IN(k) && IN((k) + 1)) { for (int r_ = 0; r_ < SYNC_REPS; ++r_) xcd_barrier(bar); } } while (0)

    if (IN(0)) {
        LAS float* scr = (LAS float*)(lds + wave * 16384);
        constexpr int I_IN = (D / 64) * (DIN / 32), I_O = (D / 64) * (D / 32), I_UP = (D / 64) * (FF2 / 32), I_DN = (FF / 64) * (D / 32);
        for (int it = gw; it < I_IN + I_O + I_UP + I_DN; it += NGW) { int r = it;
            if (r < I_IN) { p0_transpose_item(p.w_in, D, DIN, Wt_in, false, scr, r, lane); continue; } r -= I_IN;
            if (r < I_O) { p0_transpose_item(p.w_o, D, D, Wt_o, false, scr, r, lane); continue; } r -= I_O;
            if (r < I_UP) { p0_transpose_item(p.w_up, D, FF2, Wt_up, true, scr, r, lane); continue; } r -= I_UP;
            p0_transpose_item(p.w_down, FF, D, Wt_dn, false, scr, r, lane); }
        for (int idx = bx * 512 + tid; idx < 2 * 8 * 8 * 64 * 8; idx += G * 512) { const int j = idx & 7, ln = (idx >> 3) & 63, f = (idx >> 9) & 7, hh = (idx >> 12) & 7, mat = idx >> 15;
            const int d = (f >> 2) * 32 + (ln >> 4) * 8 + j, e = (f & 3) * 16 + (ln & 15);
            ((bf16*)(ws + WS_WRF))[idx] = (bf16)f2bf((mat ? p.w_i : p.w_r)[(size_t)hh * 4096 + d * 64 + e]); }
        for (int m = gw; m < M; m += NGW) row_pre1(p, m, lane);
        __syncthreads();
    }
    SEAM(0);
    if (IN(1)) { pg8::Gemm g{XN, Wt_in, MP, DIN, D, D}; pg8::StaticOrder S; S.init(MP, DIN, G, bx);
        pg8::EpiBf16<0> E{Zb, DIN, nullptr, 0, 0, 1.f};
        pg8::gemm_phase<pg8::EpiBf16<0>, pg8::StaticOrder, true, true>(lds, g, S, E);
        pg8::Gemm g2{XN, Wt_in, M, DIN, 256, D}; pg8::SplitOrder S2; S2.init(64, 4, 8, 4, 256, bx);
        pg8::EpiF32 E2{(float*)(ws + WS_ZP), DIN, nullptr, 64, (size_t)1024 * DIN};
        pg8::gemm_phase<pg8::EpiF32, pg8::SplitOrder, true, true>(lds, g2, S2, E2); }
    SEAM(1);
    for (int rep_ = 0; rep_ < MIX_REPS; ++rep_) {
    if (IN(2)) {
        for (int idx = bx * 512 + tid; idx < 1024 * (DIN / 8); idx += G * 512) {
            const f32x4* zp = (const f32x4*)(ws + WS_ZP) + (size_t)idx * 2; constexpr size_t SS = (size_t)1024 * DIN / 4;
            const f32x4 a = (zp[0] + zp[SS]) + (zp[2 * SS] + zp[3 * SS]), b2 = (zp[1] + zp[SS + 1]) + (zp[2 * SS + 1] + zp[3 * SS + 1]);
            v4u o; o.x = pk2(a.x, a.y); o.y = pk2(a.z, a.w); o.z = pk2(b2.x, b2.y); o.w = pk2(b2.z, b2.w);
            *((v4u*)(Zb + (size_t)MP * DIN) + idx) = o; }
        for (int it = bx; it < NB * 31; it += G) { const int q = (it / 31) * 32 + it % 31; mixer_a_item<false>(p, lds, q, wave, lane); } }
    SEAM(2);
    if (IN(3)) { for (int it = bx; it < 272 + 144; it += G) { if (it < 272) mixer_a_item<true>(p, lds, it, wave, lane); else mixer_b_item(p, lds, it - 272, wave, lane); } }
    SEAM(3);
    }
    if (IN(4)) { pg8::Gemm g{MIX, Wt_o, MP, D, D, D}; pg8::StaticOrder S; S.init(MP, D, G, bx);
        pg8::EpiF32 E{p.out + O_Y, D, nullptr, 0, 0};
        pg8::gemm_phase<pg8::EpiF32, pg8::StaticOrder, true, true>(lds, g, S, E);
        pg8::Gemm g2{MIX, Wt_o, M, D, 256, D}; pg8::SplitOrder S2; S2.init(64, 4, 4, 4, 256, bx);
        pg8::EpiF32 E2{(float*)(ws + WS_YP), D, nullptr, 64, (size_t)1024 * D};
        pg8::gemm_phase<pg8::EpiF32, pg8::SplitOrder, true, true>(lds, g2, S2, E2); }
    SEAM(4);
    if (IN(5)) { for (int m = gw; m < M; m += NGW) row_post1(p, m, lane); }
    SEAM(5);
    if (IN(6)) { pg8::Gemm g{XNB, Wt_up, 512, FF2, D, D}; pg8::StaticOrder S; S.init(512, FF2, G, bx);
        pg8::EpiBf16<0> E{UB, FF2, nullptr, 0, 0, 1.f};
        pg8::gemm_phase<pg8::EpiBf16<0>, pg8::StaticOrder, true, true>(lds, g, S, E); }
    SEAM(6);
    if (IN(7)) { pg8::Gemm g{XN, Wt_up, M, FF2, D, D}; pg8::StaticOrder S; S.init(M, FF2, G, bx);
        pg8::EpiConvGeglu E{HB, UB, p.st_ffn, p.w_conv_f, p.b_conv_f, p.out + O_FP, p.out + O_FS};
        pg8::gemm_phase<pg8::EpiConvGeglu, pg8::StaticOrder, true, true>(lds, g, S, E); }
    SEAM(7);
    if (IN(8)) { pg8::Gemm g{HB, Wt_dn, MP, D, FF, FF}; pg8::StaticOrder S; S.init(MP, D, G, bx);
        pg8::EpiF32 E{Fb, D, nullptr, 0, 0};
        pg8::gemm_phase<pg8::EpiF32, pg8::StaticOrder, true, true>(lds, g, S, E);
        pg8::Gemm g2{HB, Wt_dn, M, D, 384, FF}; pg8::SplitOrder S2; S2.init(64, 4, 4, 8, 384, bx);
        pg8::EpiF32 E2{(float*)(ws + WS_FP), D, nullptr, 64, (size_t)1024 * D};
        pg8::gemm_phase<pg8::EpiF32, pg8::SplitOrder, true, true>(lds, g2, S2, E2); }
    SEAM(8);
    if (IN(9)) { for (int m = gw; m < M; m += NGW) row_post2(p, m, lane); }
#undef IN
#undef SEAM
}

extern "C" void kernel_launch(void* const* d_in, const int* in_sizes, int n_in, void* d_out, int out_size, void* d_ws, size_t ws_size, hipStream_t stream) {
    static int grid = 0;
    if (grid == 0) {
        if (n_in != 28 || (size_t)out_size != O_END || ws_size < WS_END) { fprintf(stderr, "kernel_launch: unexpected shapes: n_in %d out %d ws %zu\n", n_in, out_size, ws_size); grid = -1; return; }
        int dev = 0, cus = 0, per_cu = 0;
        if (hipGetDevice(&dev) != hipSuccess || hipDeviceGetAttribute(&cus, hipDeviceAttributeMultiprocessorCount, dev) != hipSuccess) { grid = -1; return; }
        if (hipFuncSetAttribute((const void*)fwd, hipFuncAttributeMaxDynamicSharedMemorySize, LDS_BYTES) != hipSuccess) { fprintf(stderr, "kernel_launch: hipFuncSetAttribute failed\n"); grid = -1; return; }
        if (hipOccupancyMaxActiveBlocksPerMultiprocessor(&per_cu, (const void*)fwd, 512, LDS_BYTES) != hipSuccess || per_cu < 1) { fprintf(stderr, "kernel_launch: occupancy query failed (%d)\n", per_cu); (void)hipGetLastError(); per_cu = 1; }
        grid = cus * 1;
        if (grid > 256) grid = 256;
    }
    if (grid < 0) return;
    if (hipMemsetAsync((char*)d_ws + WS_CTL, 0, CTL_ZERO_BYTES, stream) != hipSuccess) { fprintf(stderr, "kernel_launch: memset failed\n"); return; }
    Args a{};
    for (int i = 0; i < 28; ++i) a.in[i] = (const float*)d_in[i];
    a.out = (float*)d_out; a.ws = (unsigned char*)d_ws; a.ph_lo = 0; a.ph_hi = NPH;
    void* kargs[] = {&a};
    const hipError_t e = hipLaunchCooperativeKernel((const void*)fwd, dim3(grid), dim3(512), kargs, LDS_BYTES, stream);
    if (e != hipSuccess) fprintf(stderr, "kernel_launch: cooperative launch failed: %s (grid %d)\n", hipGetErrorString(e), grid);
}
```

```cpp
#include <hip/hip_runtime.h>
#include <cstdio>
#include <cstdint>
namespace pg8 {
#define PG8_LAS __attribute__((address_space(3)))
typedef unsigned short bf16_t;
typedef short bf16x8 __attribute__((ext_vector_type(8)));
typedef float f32x4 __attribute__((ext_vector_type(4)));
typedef unsigned u32x4 __attribute__((ext_vector_type(4)));
constexpr int BM = 256, BK = 64, HALF = 128, HTB = HALF * BK * 2  , STAGE_BYTES = 8 * HTB, NXCD = 8, WGM = 8;

__host__ __device__ __forceinline__ int lds_byte(int r, int c) { const int st = (r >> 4) * 2 + (c >> 5), rr = r & 15, cc = c & 31, ob = rr * 64 + cc * 2; return st * 1024 + (ob ^ (((ob >> 9) & 1) << 5)); }
__host__ __device__ __forceinline__ void stage_rc(int b, int& R, int& C) { const int st = b / 1024, sb = b % 1024, swz = sb ^ (((sb >> 9) & 1) << 5); R = (st >> 1) * 16 + swz / 64; C = (st & 1) * 32 + (swz % 64) / 2; }
__host__ __device__ __forceinline__ int perm32(int rho) { const int n = rho >> 4, i = rho & 15; return 8 * (i >> 2) + 4 * n + (i & 3); }

struct Unit { int pm, pn, k0, ks, nt; };
struct Gemm { const bf16_t* A; const bf16_t* Bt; int M, N, K, ld; };

struct StaticOrder {
    int nM, nN, nwg, G, c, nt;
    __host__ __device__ void init(int M, int N, int Kc, int G_, int c_) { nM = M / BM; nN = N / BM; nwg = nM * nN; G = G_; c = c_; nt = Kc / BK; }
    __host__ __device__ bool next(int i, Unit& u) const {
        const long L = (long)i * G + c; if (L >= nwg) return false;
        int wgid = (int)L; { const int q = nwg / NXCD, r = nwg % NXCD, xcd = wgid % NXCD, off = wgid / NXCD; wgid = (xcd < r ? xcd * (q + 1) : r * (q + 1) + (xcd - r) * q) + off; }
        const int nig = WGM * nN, gid = wgid / nig, fm = gid * WGM, gsz = (nM - fm) < WGM ? (nM - fm) : WGM;
        u.pm = fm + ((wgid % nig) % gsz); u.pn = (wgid % nig) / gsz; u.k0 = 0; u.ks = 0; u.nt = nt; return true;
    }
    __device__ __forceinline__ void a_ready(const Unit&) const {}
    __device__ __forceinline__ void done(const Unit&) const {}
};

struct ComboOrder {
    StaticOrder st; int nst, pm0, nP, nN2, nS, ntS;
    __host__ __device__ void init(int M, int N, int K, int G_, int c_, int pm0_, int nP_, int nS_) { st.init(M, N, K, G_, c_); nst = c_ < st.nwg ? (st.nwg - c_ + G_ - 1) / G_ : 0;
        pm0 = pm0_; nP = nP_; nN2 = N / BM; nS = nS_; ntS = K / BK / nS_; }
    __host__ __device__ bool next(int i, Unit& u) const {
        if (i < nst) return st.next(i, u);
        const int c = st.c; if (i > nst || c >= nP * nN2 * nS) return false;
        u.ks = c % nS; u.pn = (c / nS) % nN2; u.pm = pm0 + c / (nS * nN2); u.k0 = u.ks * ntS * BK; u.nt = ntS; return true;
    }
    __device__ __forceinline__ void a_ready(const Unit&) const {}
    __device__ __forceinline__ void done(const Unit&) const {}
};
__device__ __forceinline__ unsigned cvt_pk_bf16(float lo, float hi) { unsigned r; asm volatile("v_cvt_pk_bf16_f32 %0, %1, %2" : "=v"(r) : "v"(lo), "v"(hi)); return r; }
typedef float f32x2 __attribute__((ext_vector_type(2)));
__device__ __forceinline__ f32x2 gelu_pk(f32x2 v) {
    const f32x2 av = __builtin_elementwise_abs(v), d = av * 0.2316418882f + 1.0f;
    f32x2 t; t.x = __builtin_amdgcn_rcpf(d.x); t.y = __builtin_amdgcn_rcpf(d.y);
    f32x2 q = t * 0.5307027145f + (-0.7265760135f); q = q * t + 0.7107068705f; q = q * t + (-0.142248368f); q = q * t + 0.127414796f; q = q * t;
    const f32x2 s = (v * v) * (-0.72134752044f);
    f32x2 e; e.x = __builtin_amdgcn_exp2f(s.x); e.y = __builtin_amdgcn_exp2f(s.y);
    const f32x2 m = v * (q * e), r = v - m;
    f32x2 o; o.x = v.x < 0.f ? m.x : r.x; o.y = v.y < 0.f ? m.y : r.y; return o;
}

template <int ACT  > struct EpiBf16 {
    static constexpr bool PERM = true, AFTER_DRAIN = false; static_assert(ACT == 0 || ACT == 1, "EpiBf16: ACT is 0 (none) or 1 (gelu_pk)");
    bf16_t* O; int ldc; const float* bias; int split_cols; size_t split_stride; float scale0;
    __device__ __forceinline__ void operator()(const f32x4 (&acc)[2][2][4][2], const Unit& u, int wr, int wc, int fr, int fq) const {
        const int row0 = u.pm * BM + wr * 64 + fr; int colt = u.pn * BM; bf16_t* base = O;
        float sc = 1.f; if (split_cols) { const int t = colt / split_cols; base += (size_t)t * split_stride; colt -= t * split_cols; if (t == 0) sc = scale0; }
        const int col0 = colt + wc * 32 + 8 * fq, bcol0 = u.pn * BM + wc * 32 + 8 * fq;
        f32x4 bv[2][2];
#pragma unroll
        for (int bj = 0; bj < 2; ++bj)
#pragma unroll
            for (int n = 0; n < 2; ++n) bv[bj][n] = bias ? *(const f32x4*)(bias + bcol0 + bj * HALF + 4 * n) : (f32x4){0.f, 0.f, 0.f, 0.f};
#pragma unroll
        for (int ai = 0; ai < 2; ++ai)
#pragma unroll
            for (int m = 0; m < 4; ++m) { bf16_t* rowp = base + (size_t)(row0 + ai * HALF + m * 16) * ldc + col0;
#pragma unroll
                for (int bj = 0; bj < 2; ++bj) { f32x4 v0 = acc[ai][bj][m][0] + bv[bj][0], v1 = acc[ai][bj][m][1] + bv[bj][1];
                    if (ACT == 1) { f32x2 a = gelu_pk((f32x2){v0[0], v0[1]}), b = gelu_pk((f32x2){v0[2], v0[3]}), c = gelu_pk((f32x2){v1[0], v1[1]}), d = gelu_pk((f32x2){v1[2], v1[3]});
                        v0 = (f32x4){a.x, a.y, b.x, b.y}; v1 = (f32x4){c.x, c.y, d.x, d.y}; }
                    v0 = v0 * sc; v1 = v1 * sc; u32x4 w; w.x = cvt_pk_bf16(v0[0], v0[1]); w.y = cvt_pk_bf16(v0[2], v0[3]); w.z = cvt_pk_bf16(v1[0], v1[1]); w.w = cvt_pk_bf16(v1[2], v1[3]);
                    *(u32x4*)(rowp + bj * HALF) = w; } }
    }
};
struct EpiF32 {
    static constexpr bool PERM = false, AFTER_DRAIN = false;
    float* C; int ldc; const float* bias; int pm0; float* C1; size_t ks_stride;
    __device__ __forceinline__ void operator()(const f32x4 (&acc)[2][2][4][2], const Unit& u, int wr, int wc, int fr, int fq) const {
        const bool sp = u.pm >= pm0; const int row0 = (sp ? u.pm - pm0 : u.pm) * BM + wr * 64 + fr, col0 = u.pn * BM + wc * 32 + 4 * fq; float* C = sp ? C1 + (size_t)u.ks * ks_stride : this->C;
        f32x4 bv[2][2];
#pragma unroll
        for (int bj = 0; bj < 2; ++bj)
#pragma unroll
            for (int n = 0; n < 2; ++n) bv[bj][n] = bias ? *(const f32x4*)(bias + col0 + bj * HALF + n * 16) : (f32x4){0.f, 0.f, 0.f, 0.f};
#pragma unroll
        for (int ai = 0; ai < 2; ++ai)
#pragma unroll
            for (int m = 0; m < 4; ++m) { float* rowp = C + (size_t)(row0 + ai * HALF + m * 16) * ldc + col0;
#pragma unroll
                for (int bj = 0; bj < 2; ++bj)
#pragma unroll
                    for (int n = 0; n < 2; ++n) *(f32x4*)(rowp + bj * HALF + n * 16) = acc[ai][bj][m][n] + bv[bj][n]; }
    }
};
__device__ __forceinline__ float dpp_shr1(float old, float src) { return __builtin_bit_cast(float, __builtin_amdgcn_update_dpp(__builtin_bit_cast(int, old), __builtin_bit_cast(int, src), 0x111, 0xf, 0xf, false)); }
__device__ __forceinline__ float dpp_shr2(float old, float src) { return __builtin_bit_cast(float, __builtin_amdgcn_update_dpp(__builtin_bit_cast(int, old), __builtin_bit_cast(int, src), 0x112, 0xf, 0xf, false)); }
__device__ __forceinline__ float dpp_ror1(float src) { return __builtin_bit_cast(float, __builtin_amdgcn_update_dpp(0, __builtin_bit_cast(int, src), 0x121, 0xf, 0xf, false)); }
__device__ __forceinline__ float dpp_ror2(float src) { return __builtin_bit_cast(float, __builtin_amdgcn_update_dpp(0, __builtin_bit_cast(int, src), 0x122, 0xf, 0xf, false)); }
__device__ __forceinline__ float gelu_tanh(float x) {
    const float t = x * x, inner = x * (2.302208198f + 0.102943240f * t);
    return x * __builtin_amdgcn_rcpf(1.0f + __builtin_amdgcn_exp2f(-inner));
}
__device__ __forceinline__ f32x4 bf4_to_f4(const bf16_t* p) { const unsigned long long w = *(const unsigned long long*)p;
    return (f32x4){__builtin_bit_cast(float, (unsigned)(w << 16)), __builtin_bit_cast(float, (unsigned)w & 0xffff0000u), __builtin_bit_cast(float, (unsigned)(w >> 32) << 16), __builtin_bit_cast(float, (unsigned)(w >> 32) & 0xffff0000u)}; }

struct EpiConvGeglu {
    static constexpr bool PERM = true, AFTER_DRAIN = false;
    bf16_t* HB;
    const bf16_t* UB;
    const float* state;
    const float* wcv;
    const float* bcv;
    float* out_p;
    float* out_s;
    __device__ __forceinline__ void operator()(const f32x4 (&acc)[2][2][4][2], const Unit& u, int wr, int wc, int fr, int fq) const {
        const int cgb = u.pn * 128 + wc * 32 + 8 * fq;
        const int npb = u.pn * 256 + wc * 32 + 8 * fq;
#pragma unroll
        for (int n = 0; n < 2; ++n) {
            const int cg = cgb + 4 * n;
            const f32x4 w0g = *(const f32x4*)(wcv + cg), w1g = *(const f32x4*)(wcv + 6144 + cg), w2g = *(const f32x4*)(wcv + 12288 + cg), bg = *(const f32x4*)(bcv + cg);
            const f32x4 w0v = *(const f32x4*)(wcv + 3072 + cg), w1v = *(const f32x4*)(wcv + 6144 + 3072 + cg), w2v = *(const f32x4*)(wcv + 12288 + 3072 + cg), bv = *(const f32x4*)(bcv + 3072 + cg);
#pragma unroll
            for (int ai = 0; ai < 2; ++ai) {
                const int r0 = u.pm * BM + ai * HALF + wr * 64;
                f32x4 c1g, c2g, c1v, c2v;
                if (r0 >= 16384) { const float* st = state + (size_t)((r0 - 16384) >> 6) * 2 * 6144;
                    c2g = *(const f32x4*)(st + cg); c1g = *(const f32x4*)(st + 6144 + cg); c2v = *(const f32x4*)(st + 3072 + cg); c1v = *(const f32x4*)(st + 6144 + 3072 + cg); }
                else if ((r0 & 2047) == 0) { c1g = c2g = c1v = c2v = (f32x4){0.f, 0.f, 0.f, 0.f}; }
                else { const bf16_t* ub = UB + (size_t)(2 * (r0 >> 6)) * 6144 + npb + 4 * n;
                    c2g = bf4_to_f4(ub); c1g = bf4_to_f4(ub + 6144); c2v = bf4_to_f4(ub + 128); c1v = bf4_to_f4(ub + 6144 + 128); }
#pragma unroll
                for (int m = 0; m < 4; ++m) {
                    const f32x4 xg = acc[ai][0][m][n], xv = acc[ai][1][m][n];
                    f32x4 o1g, o2g, o1v, o2v;
                    if (m == 0) { o1g = c1g; o1v = c1v; o2g = (fr == 0) ? c2g : c1g; o2v = (fr == 0) ? c2v : c1v; }
                    else { const f32x4 pg = acc[ai][0][m > 0 ? m - 1 : 0][n], pv = acc[ai][1][m > 0 ? m - 1 : 0][n];
#pragma unroll
                        for (int e = 0; e < 4; ++e) { o1g[e] = dpp_ror1(pg[e]); o2g[e] = dpp_ror2(pg[e]); o1v[e] = dpp_ror1(pv[e]); o2v[e] = dpp_ror2(pv[e]); } }
                    float res[4];
#pragma unroll
                    for (int e = 0; e < 4; ++e) {
                        const float g1 = dpp_shr1(o1g[e], xg[e]), g2 = dpp_shr2(o2g[e], xg[e]);
                        const float v1 = dpp_shr1(o1v[e], xv[e]), v2 = dpp_shr2(o2v[e], xv[e]);
                        const float cgv = bg[e] + w0g[e] * g2 + w1g[e] * g1 + w2g[e] * xg[e];
                        const float cvv = bv[e] + w0v[e] * v2 + w1v[e] * v1 + w2v[e] * xv[e];
                        res[e] = gelu_tanh(cgv) * cvv;
                    }
                    typedef unsigned u32x2v __attribute__((ext_vector_type(2)));
                    u32x2v w; w.x = cvt_pk_bf16(res[0], res[1]); w.y = cvt_pk_bf16(res[2], res[3]);
                    *(u32x2v*)(HB + (size_t)(r0 + 16 * m + fr) * 3072 + cg) = w;
                }
                const bool smp = r0 >= 16384;
                if ((smp || (((r0 + 64) & 2047) == 0)) && fr >= 14) {
                    float* o = (smp ? out_s + (size_t)((r0 - 16384) >> 6) * 2 * 6144 : out_p + (size_t)(r0 >> 11) * 2 * 6144) + (fr - 14) * 6144;
                    *(f32x4*)(o + cg) = acc[ai][0][3][n]; *(f32x4*)(o + 3072 + cg) = acc[ai][1][3][n];
                }
            }
        }
    }
};

struct EpiZ {
    static constexpr bool PERM = true, AFTER_DRAIN = false;
    bf16_t* O; int ldc; float* C1; size_t ks_stride;
    __device__ __forceinline__ void operator()(const f32x4 (&acc)[2][2][4][2], const Unit& u, int wr, int wc, int fr, int fq) const {
        const int col0 = u.pn * BM + wc * 32 + 8 * fq;
        if (u.pm < 64) { const int row0 = u.pm * BM + wr * 64 + fr;
#pragma unroll
            for (int ai = 0; ai < 2; ++ai)
#pragma unroll
                for (int m = 0; m < 4; ++m) { bf16_t* rowp = O + (size_t)(row0 + ai * HALF + m * 16) * ldc + col0;
#pragma unroll
                    for (int bj = 0; bj < 2; ++bj) { const f32x4 v0 = acc[ai][bj][m][0], v1 = acc[ai][bj][m][1];
                        u32x4 w; w.x = cvt_pk_bf16(v0[0], v0[1]); w.y = cvt_pk_bf16(v0[2], v0[3]); w.z = cvt_pk_bf16(v1[0], v1[1]); w.w = cvt_pk_bf16(v1[2], v1[3]);
                        *(u32x4*)(rowp + bj * HALF) = w; } }
        } else { float* C = C1 + (size_t)u.ks * ks_stride; const int row0 = (u.pm - 64) * BM + wr * 64 + fr;
#pragma unroll
            for (int ai = 0; ai < 2; ++ai)
#pragma unroll
                for (int m = 0; m < 4; ++m) { float* rowp = C + (size_t)(row0 + ai * HALF + m * 16) * ldc + col0;
#pragma unroll
                    for (int bj = 0; bj < 2; ++bj) { *(f32x4*)(rowp + bj * HALF) = acc[ai][bj][m][0]; *(f32x4*)(rowp + bj * HALF + 4) = acc[ai][bj][m][1]; } }
        }
    }
};
template <class Epi, class Sched, bool ALIGN_EPI = false, bool SP2 = false>
__device__ __forceinline__ void gemm_phase(PG8_LAS unsigned char* lds, const Gemm g, const Sched& S, const Epi& E) {
    int tid_ = threadIdx.x; asm volatile("" : "+v"(tid_));
    const int tid = tid_, wid = __builtin_amdgcn_readfirstlane(tid >> 6), lane = tid & 63, wr = wid >> 2, wc = wid & 3, fr = lane & 15, fq = lane >> 4;
    const int K = g.ld;
    unsigned voffA[2], voffB[2];
#pragma unroll
    for (int i = 0; i < 2; ++i) { int R, C; stage_rc(tid * 16 + i * 8192, R, C); const int Rb = Epi::PERM ? ((R & ~31) + perm32(R & 31)) : R;
        voffA[i] = (unsigned)(R * K + C) * 2u; voffB[i] = (unsigned)(Rb * K + C) * 2u; }
    const size_t kstep = (size_t)(BK * 2);
    const size_t hstep = (size_t)HALF * K * 2;
    const size_t tstep = 2 * hstep;
    const unsigned ldsw = (unsigned)wid * 1024u;
    const int aoff = lds_byte(wr * 64 + fr, fq * 8), boff = lds_byte(wc * 32 + fr, fq * 8);
#define PG8_SA(b, h) (((b) * 2 + (h)) * HTB)
#define PG8_SB(b, h) ((4 + (b) * 2 + (h)) * HTB)
#define PG8_STAGE(bufoff, gbase, voff) do { _Pragma("unroll") for (int _i = 0; _i < 2; ++_i) \
        __builtin_amdgcn_global_load_lds((const unsigned*)((const char*)(gbase) + (voff)[_i]), (PG8_LAS unsigned*)(lds + (bufoff) + ldsw + _i * 8192), 16, 0, 0); } while (0)
#define PG8_LDA(dst, b, h) do { _Pragma("unroll") for (int m = 0; m < 4; ++m) _Pragma("unroll") for (int k = 0; k < 2; ++k) dst[m][k] = *(const PG8_LAS bf16x8*)(lds + PG8_SA(b, h) + aoff + m * 2048 + k * 1024); } while (0)
#define PG8_LDB(dst, b, h) do { _Pragma("unroll") for (int n = 0; n < 2; ++n) _Pragma("unroll") for (int k = 0; k < 2; ++k) dst[n][k] = *(const PG8_LAS bf16x8*)(lds + PG8_SB(b, h) + boff + n * 2048 + k * 1024); } while (0)
#define PG8_MMA(ai, bj, At, Bt) do { __builtin_amdgcn_s_setprio(1); _Pragma("unroll") for (int m = 0; m < 4; ++m) _Pragma("unroll") for (int n = 0; n < 2; ++n) _Pragma("unroll") for (int k = 0; k < 2; ++k) \
        acc[ai][bj][m][n] = __builtin_amdgcn_mfma_f32_16x16x32_bf16(Bt[n][k], At[m][k], acc[ai][bj][m][n], 0, 0, 0); __builtin_amdgcn_s_setprio(0); } while (0)
#define PG8_WAIT_V(n) asm volatile("s_waitcnt vmcnt(" #n ")" ::: "memory")
#define PG8_WAIT_L(n) asm volatile("s_waitcnt lgkmcnt(" #n ")" ::: "memory")
#define PG8_BAR __builtin_amdgcn_s_barrier()
#define PG8_SCHED __builtin_amdgcn_sched_barrier(0)
    Unit cur, nxt; int ui = 0;
    if (!S.next(0, cur)) return;
    f32x4 acc[2][2][4][2];
#pragma unroll
    for (int a = 0; a < 2; ++a)
#pragma unroll
        for (int b = 0; b < 2; ++b)
#pragma unroll
            for (int m = 0; m < 4; ++m)
#pragma unroll
                for (int n = 0; n < 2; ++n) acc[a][b][m][n] = (f32x4){0.f, 0.f, 0.f, 0.f};
    bf16x8 At[4][2], B0[2][2], B1[2][2];
    const char* cA = (const char*)g.A + (size_t)cur.pm * tstep + (size_t)cur.k0 * 2; const char* cB = (const char*)g.Bt + (size_t)cur.pn * tstep + (size_t)cur.k0 * 2;
    S.a_ready(cur);
    if constexpr (SP2) {
        PG8_STAGE(PG8_SB(0, 0), cB, voffB); PG8_STAGE(PG8_SB(0, 1), cB + hstep, voffB); PG8_STAGE(PG8_SA(0, 0), cA, voffA); PG8_STAGE(PG8_SA(0, 1), cA + hstep, voffA);
        if (wr == 1) PG8_BAR;
        PG8_WAIT_V(2); PG8_BAR;
        PG8_STAGE(PG8_SB(1, 0), cB + kstep, voffB); PG8_STAGE(PG8_SA(1, 0), cA + kstep, voffA); PG8_STAGE(PG8_SB(1, 1), cB + hstep + kstep, voffB);
        PG8_WAIT_V(6); PG8_BAR;
    } else {
        PG8_STAGE(PG8_SB(0, 0), cB, voffB); PG8_STAGE(PG8_SA(0, 0), cA, voffA); PG8_STAGE(PG8_SB(0, 1), cB + hstep, voffB); PG8_STAGE(PG8_SA(0, 1), cA + hstep, voffA);
        if (wr == 1) PG8_BAR;
        PG8_WAIT_V(4); PG8_BAR;
        PG8_STAGE(PG8_SB(1, 0), cB + kstep, voffB); PG8_STAGE(PG8_SA(1, 0), cA + kstep, voffA); PG8_STAGE(PG8_SB(1, 1), cB + hstep + kstep, voffB);
        PG8_WAIT_V(6); PG8_BAR;
    }
    for (;;) {
        const bool has_next = S.next(ui + 1, nxt);
        const char* nA = has_next ? (const char*)g.A + (size_t)nxt.pm * tstep + (size_t)nxt.k0 * 2 : cA; const char* nB = has_next ? (const char*)g.Bt + (size_t)nxt.pn * tstep + (size_t)nxt.k0 * 2 : cB;
        const int nt = cur.nt;
        for (int t = 0; t < nt; t += 2) {
            const bool last = (t == nt - 2);
            const char* a1 = cA + (size_t)(t + 1) * kstep;
            const char* a2 = last ? nA : cA + (size_t)(t + 2) * kstep; const char* b2 = last ? nB : cB + (size_t)(t + 2) * kstep;
            const char* a3 = a2 + kstep; const char* b3 = b2 + kstep;
            if (last && has_next) S.a_ready(nxt);
            if constexpr (SP2) {
            PG8_LDB(B0, 0, 0); PG8_LDB(B1, 0, 1); PG8_SCHED; PG8_LDA(At, 0, 0); PG8_STAGE(PG8_SA(1, 1), a1 + hstep, voffA);
            PG8_WAIT_V(8); PG8_WAIT_L(0); PG8_BAR; PG8_MMA(0, 0, At, B0); PG8_MMA(0, 1, At, B1); PG8_BAR; PG8_SCHED;
            PG8_LDA(At, 0, 1); PG8_STAGE(PG8_SB(0, 0), b2, voffB); PG8_STAGE(PG8_SB(0, 1), b2 + hstep, voffB); PG8_STAGE(PG8_SA(0, 0), a2, voffA);
            PG8_WAIT_V(8); PG8_WAIT_L(0); PG8_BAR; PG8_MMA(1, 0, At, B0); PG8_MMA(1, 1, At, B1); PG8_BAR; PG8_SCHED;
            PG8_LDB(B0, 1, 0); PG8_LDB(B1, 1, 1); PG8_SCHED; PG8_LDA(At, 1, 0); PG8_STAGE(PG8_SA(0, 1), a2 + hstep, voffA);
            PG8_WAIT_V(8); PG8_WAIT_L(0); PG8_BAR; PG8_MMA(0, 0, At, B0); PG8_MMA(0, 1, At, B1); PG8_BAR; PG8_SCHED;
            PG8_LDA(At, 1, 1); PG8_STAGE(PG8_SB(1, 0), b3, voffB); PG8_STAGE(PG8_SB(1, 1), b3 + hstep, voffB); PG8_STAGE(PG8_SA(1, 0), a3, voffA);
            PG8_WAIT_V(8); PG8_WAIT_L(0); PG8_BAR; PG8_MMA(1, 0, At, B0); PG8_MMA(1, 1, At, B1); PG8_BAR; PG8_SCHED;
            } else {
            PG8_LDB(B0, 0, 0); PG8_SCHED; PG8_LDA(At, 0, 0); PG8_STAGE(PG8_SA(1, 1), a1 + hstep, voffA);
            PG8_WAIT_L(8); PG8_BAR; PG8_WAIT_L(0); PG8_MMA(0, 0, At, B0); PG8_BAR; PG8_SCHED;
            PG8_LDB(B1, 0, 1); PG8_STAGE(PG8_SB(0, 0), b2, voffB);
            PG8_BAR; PG8_WAIT_L(0); PG8_MMA(0, 1, At, B1); PG8_BAR;
            PG8_LDA(At, 0, 1); PG8_STAGE(PG8_SA(0, 0), a2, voffA);
            PG8_BAR; PG8_WAIT_L(0); PG8_MMA(1, 0, At, B0); PG8_BAR; PG8_SCHED;
            PG8_STAGE(PG8_SB(0, 1), b2 + hstep, voffB);
            PG8_WAIT_V(6); PG8_BAR; PG8_MMA(1, 1, At, B1); PG8_BAR;
            PG8_LDB(B0, 1, 0); PG8_SCHED; PG8_LDA(At, 1, 0); PG8_STAGE(PG8_SA(0, 1), a2 + hstep, voffA);
            PG8_WAIT_L(8); PG8_BAR; PG8_WAIT_L(0); PG8_MMA(0, 0, At, B0); PG8_BAR; PG8_SCHED;
            PG8_LDB(B1, 1, 1); PG8_STAGE(PG8_SB(1, 0), b3, voffB);
            PG8_BAR; PG8_WAIT_L(0); PG8_MMA(0, 1, At, B1); PG8_BAR;
            PG8_LDA(At, 1, 1); PG8_STAGE(PG8_SA(1, 0), a3, voffA);
            PG8_BAR; PG8_WAIT_L(0); PG8_MMA(1, 0, At, B0); PG8_BAR; PG8_SCHED;
            PG8_STAGE(PG8_SB(1, 1), b3 + hstep, voffB);
            PG8_WAIT_V(6); PG8_BAR; PG8_MMA(1, 1, At, B1); PG8_BAR;
            }
        }
        if constexpr (ALIGN_EPI) { if (wr == 0) PG8_BAR; }
        if constexpr (!Epi::AFTER_DRAIN) { E(acc, cur, wr, wc, fr, fq); S.done(cur); }
        if (!has_next) break;
#pragma unroll
        for (int a = 0; a < 2; ++a)
#pragma unroll
            for (int b = 0; b < 2; ++b)
#pragma unroll
                for (int m = 0; m < 4; ++m)
#pragma unroll
                    for (int n = 0; n < 2; ++n) acc[a][b][m][n] = (f32x4){0.f, 0.f, 0.f, 0.f};
        cur = nxt; cA = nA; cB = nB; ++ui;
        if constexpr (ALIGN_EPI) { if (wr == 1) PG8_BAR; }
    }
    PG8_WAIT_V(0);
    if constexpr (!ALIGN_EPI) { if (wr == 0) PG8_BAR; }
    PG8_BAR;
    if constexpr (Epi::AFTER_DRAIN) { E.fused(acc, cur, wr, wc, fr, fq, lds, wid, lane); S.done(cur); }
#undef PG8_SA
#undef PG8_SB
#undef PG8_STAGE
#undef PG8_LDA
#undef PG8_LDB
#undef PG8_MMA
#undef PG8_WAIT_V
#undef PG8_WAIT_L
#undef PG8_BAR
#undef PG8_SCHED
}
}

constexpr int D = 1024, NB = 8, SEQ = 2048, NS = 16, SSEQ = 64, MP = NB * SEQ, M = MP + NS * SSEQ;
constexpr int DA = 512, DB = 512, DIN = 2048, FF = 3072, FF2 = 6144;
constexpr float EPS = 1e-6f;
constexpr size_t O_Y = 0, O_HP = (size_t)M * D, O_CP = O_HP + NB * DA, O_FP = O_CP + NB * 3 * DA, O_HS = O_FP + NB * 2 * FF2, O_CS = O_HS + NS * DA, O_FS = O_CS + NS * 3 * DA, O_VS = O_FS + NS * 2 * FF2,
                 O_END = O_VS + (size_t)NS * SSEQ * DB;
constexpr size_t MiB = 1u << 20;
constexpr size_t WS_CTL = 0, CTL_ZERO_BYTES = 65536;
constexpr size_t WS_WIN = 2 * MiB, WS_WO = 6 * MiB, WS_WUP = 8 * MiB, WS_WDN = 20 * MiB, WS_XN = 26 * MiB, WS_Z = 60 * MiB, WS_MIX = 128 * MiB, WS_HB = 60 * MiB, WS_F = 162 * MiB,
                 WS_XNB = 230 * MiB, WS_UB = 231 * MiB, WS_AGG = 237 * MiB, WS_WRF = 238 * MiB, WS_WSF = 238 * MiB + 262144  , WS_END = 239 * MiB,
                 WS_ZP = 162 * MiB  , WS_YP = 162 * MiB  ,
                 WS_FP = 26 * MiB  , WS_UBP = 162 * MiB  ;
constexpr int LDS_BYTES = 147456;

#define GAS __attribute__((address_space(1)))
#define LAS __attribute__((address_space(3)))
typedef unsigned short bf16;
typedef float f32x4 __attribute__((ext_vector_type(4)));
typedef short bf16x8 __attribute__((ext_vector_type(8)));
typedef unsigned v4u __attribute__((ext_vector_type(4)));
typedef unsigned v2u __attribute__((ext_vector_type(2)));
#define LDS_WAIT() asm volatile("s_waitcnt lgkmcnt(0)" ::: "memory")

__device__ __forceinline__ unsigned f2bf(float f) { unsigned u = __builtin_bit_cast(unsigned, f); return (u + 0x7fffu + ((u >> 16) & 1u)) >> 16; }
__device__ __forceinline__ unsigned pk2(float lo, float hi) { return f2bf(lo) | (f2bf(hi) << 16); }
__device__ __forceinline__ float bf2f(bf16 b) { return __builtin_bit_cast(float, (unsigned)b << 16); }
__device__ __forceinline__ float wave_sum(float v) {
#pragma unroll
    for (int o = 1; o < 64; o <<= 1) v += __shfl_xor(v, o);
    return v;
}
__device__ __forceinline__ float sigmoidf_(float z) { return __builtin_amdgcn_rcpf(1.0f + __builtin_amdgcn_exp2f(-1.4426950408889634f * z)); }

__device__ __forceinline__ void p0_transpose_item(const float* W, int K, int N, bf16* WT, bool up_perm, LAS float* scr, int item, int lane) {
    const int nblk = N / 32, kb = item / nblk, nb = item % nblk, k0 = 64 * kb, n0 = 32 * nb;
#pragma unroll
    for (int i = 0; i < 32; ++i) { const int kk = 2 * i + (lane >> 5); scr[kk * 33 + (lane & 31)] = W[(size_t)(k0 + kk) * N + n0 + (lane & 31)]; }
    LDS_WAIT(); asm volatile("" ::: "memory");
    int rb = n0; if (up_perm) { const int hi = n0 >= FF ? 1 : 0, cc = n0 - hi * FF; rb = (cc >> 7) * 256 + hi * 128 + (cc & 127); }
    const int c = lane & 7;
#pragma unroll
    for (int j = 0; j < 4; ++j) { const int n = (lane >> 3) + 8 * j; const LAS float* s = scr + (8 * c) * 33 + n;
        v4u o; o.x = pk2(s[0 * 33], s[1 * 33]); o.y = pk2(s[2 * 33], s[3 * 33]); o.z = pk2(s[4 * 33], s[5 * 33]); o.w = pk2(s[6 * 33], s[7 * 33]);
        *(v4u*)(WT + (size_t)(rb + n) * K + k0 + 8 * c) = o; }
    LDS_WAIT(); asm volatile("" ::: "memory");
}

struct P {
    const float *xp, *xs, *st_h, *st_conv, *st_ffn, *g_pre1, *w_in, *w_conv_a, *b_conv_a, *w_r, *b_r, *w_i, *b_i, *lam, *g_out_a, *g_v, *b_v, *w_s, *b_s, *g_out_b, *w_o, *g_post1, *g_pre2, *w_up,
                *w_conv_f, *b_conv_f, *w_down, *g_post2;
    float* out; unsigned char* ws;
};
__device__ __forceinline__ const float* xrow(const P& p, int m) { return m < MP ? p.xp + (size_t)m * D : p.xs + (size_t)(m - MP) * D; }

template <int R> __device__ __forceinline__ void wave_sum_n(float (&v)[R]) {
#pragma unroll
    for (int o = 1; o < 64; o <<= 1) {
#pragma unroll
        for (int r = 0; r < R; ++r) v[r] += __shfl_xor(v[r], o); }
}
__device__ __forceinline__ float sumsq4(const f32x4 v) { return (v.x * v.x + v.y * v.y) + (v.z * v.z + v.w * v.w); }
__device__ __forceinline__ unsigned long long pk4(const f32x4 v) { return (unsigned long long)pk2(v.x, v.y) | ((unsigned long long)pk2(v.z, v.w) << 32); }
template <int R> __device__ __forceinline__ void rows_pre1(const P& p, int m0, int lane) {
    const f32x4* gr = (const f32x4*)p.g_pre1 + lane;
    f32x4 v[R][4]; float s[R];
#pragma unroll
    for (int r = 0; r < R; ++r) { const f32x4* xr = (const f32x4*)xrow(p, m0 + r) + lane;
#pragma unroll
        for (int j = 0; j < 4; ++j) v[r][j] = xr[64 * j]; }
#pragma unroll
    for (int r = 0; r < R; ++r) { s[r] = 0.f;
#pragma unroll
        for (int j = 0; j < 4; ++j) s[r] += sumsq4(v[r][j]); }
    wave_sum_n<R>(s);
    f32x4 g[4];
#pragma unroll
    for (int j = 0; j < 4; ++j) g[j] = gr[64 * j];
#pragma unroll
    for (int r = 0; r < R; ++r) { const float rs = 1.0f / sqrtf(s[r] * (1.f / D) + EPS);
        unsigned long long* o8 = (unsigned long long*)((bf16*)(p.ws + WS_XN) + (size_t)(m0 + r) * D) + lane;
#pragma unroll
        for (int j = 0; j < 4; ++j) o8[64 * j] = pk4(v[r][j] * rs * g[j]); }
}
template <int R> __device__ __forceinline__ void rows_post1(const P& p, int m0, int lane) {
    const f32x4* g1 = (const f32x4*)p.g_post1 + lane; const f32x4* g2 = (const f32x4*)p.g_pre2 + lane;
    f32x4 y[R][4], x[R][4]; float s[R];
#pragma unroll
    for (int r = 0; r < R; ++r) { const int m = m0 + r; const f32x4* xr = (const f32x4*)xrow(p, m) + lane; const f32x4* yr = (const f32x4*)(p.out + O_Y + (size_t)m * D) + lane;
#pragma unroll
        for (int j = 0; j < 4; ++j) { x[r][j] = xr[64 * j];
            if (m < MP) y[r][j] = yr[64 * j];
            else { const f32x4* yp = (const f32x4*)((const float*)(p.ws + WS_YP) + (size_t)(m - MP) * D) + lane + 64 * j; y[r][j] = (yp[0] + yp[262144]) + (yp[2 * 262144] + yp[3 * 262144]); } } }
#pragma unroll
    for (int r = 0; r < R; ++r) { s[r] = 0.f;
#pragma unroll
        for (int j = 0; j < 4; ++j) s[r] += sumsq4(y[r][j]); }
    wave_sum_n<R>(s);
    f32x4 gg[4];
#pragma unroll
    for (int j = 0; j < 4; ++j) gg[j] = g1[64 * j];
    float s2[R];
#pragma unroll
    for (int r = 0; r < R; ++r) { const float rs = 1.0f / sqrtf(s[r] * (1.f / D) + EPS); f32x4* yr = (f32x4*)(p.out + O_Y + (size_t)(m0 + r) * D) + lane; s2[r] = 0.f;
#pragma unroll
        for (int j = 0; j < 4; ++j) { y[r][j] = x[r][j] + y[r][j] * rs * gg[j]; yr[64 * j] = y[r][j]; s2[r] += sumsq4(y[r][j]); } }
    wave_sum_n<R>(s2);
#pragma unroll
    for (int j = 0; j < 4; ++j) gg[j] = g2[64 * j];
#pragma unroll
    for (int r = 0; r < R; ++r) { const int m = m0 + r; const float rs2 = 1.0f / sqrtf(s2[r] * (1.f / D) + EPS);
        unsigned long long* o8 = (unsigned long long*)((bf16*)(p.ws + WS_XN) + (size_t)m * D) + lane;
        unsigned long long* b8 = nullptr;
        if (m < MP - 64 && (m & 63) >= 62) b8 = (unsigned long long*)((bf16*)(p.ws + WS_XNB) + (size_t)(2 * ((m >> 6) + 1) + (m & 63) - 62) * D) + lane;
#pragma unroll
        for (int j = 0; j < 4; ++j) { const unsigned long long w = pk4(y[r][j] * rs2 * gg[j]); o8[64 * j] = w; if (b8) b8[64 * j] = w; } }
}
template <int R> __device__ __forceinline__ void rows_post2(const P& p, int m0, int lane) {
    const f32x4* g1 = (const f32x4*)p.g_post2 + lane;
    f32x4 y[R][4], x[R][4]; float s[R];
#pragma unroll
    for (int r = 0; r < R; ++r) { const int m = m0 + r; const f32x4* fr = (const f32x4*)((const float*)(p.ws + WS_F) + (size_t)m * D) + lane; const f32x4* yr = (const f32x4*)(p.out + O_Y + (size_t)m * D) + lane;
#pragma unroll
        for (int j = 0; j < 4; ++j) { x[r][j] = yr[64 * j];
            if (m < MP) y[r][j] = fr[64 * j];
            else { const f32x4* fp = (const f32x4*)((const float*)(p.ws + WS_FP) + (size_t)(m - MP) * D) + lane + 64 * j;
                y[r][j] = ((fp[0] + fp[262144]) + (fp[2 * 262144] + fp[3 * 262144])) + ((fp[4 * 262144] + fp[5 * 262144]) + (fp[6 * 262144] + fp[7 * 262144])); } } }
#pragma unroll
    for (int r = 0; r < R; ++r) { s[r] = 0.f;
#pragma unroll
        for (int j = 0; j < 4; ++j) s[r] += sumsq4(y[r][j]); }
    wave_sum_n<R>(s);
    f32x4 gg[4];
#pragma unroll
    for (int j = 0; j < 4; ++j) gg[j] = g1[64 * j];
#pragma unroll
    for (int r = 0; r < R; ++r) { const float rs = 1.0f / sqrtf(s[r] * (1.f / D) + EPS); f32x4* yr = (f32x4*)(p.out + O_Y + (size_t)(m0 + r) * D) + lane;
#pragma unroll
        for (int j = 0; j < 4; ++j) yr[64 * j] = x[r][j] + y[r][j] * rs * gg[j]; }
}

constexpr int MA_WL = 10752, MA_YS = 8 * MA_WL;
template <bool FINAL>
__device__ __forceinline__ void mixer_a_item(const P& p, LAS unsigned char* lds, int q, int wave, int lane) {
    asm volatile("" : "+v"(lane));
    const bool smp = q >= 256; const int b = q >> 5, cc = q & 31, sidx = q - 256;
    const int row0 = smp ? MP + sidx * SSEQ : b * SEQ + cc * 64;
    const int c = wave * 64 + lane;
    const bf16* Z = (const bf16*)(p.ws + WS_Z);
    float* AGG = (float*)(p.ws + WS_AGG);
    LAS unsigned char* wl = lds + wave * MA_WL;
    LAS bf16* XC = (LAS bf16*)wl;
    LAS float* RB = (LAS float*)(wl + 2560);
    LAS float* IB = (LAS float*)(wl + 2560 + 4096);
    LAS float* YS = (LAS float*)(lds + MA_YS);
    const bf16x8* wfrag = (const bf16x8*)(p.ws + WS_WRF) + (size_t)wave * 8 * 64 + lane;
    const float cw0 = p.w_conv_a[c], cw1 = p.w_conv_a[DA + c], cw2 = p.w_conv_a[2 * DA + c], cw3 = p.w_conv_a[3 * DA + c], cb = p.b_conv_a[c];
    const float br = p.b_r[c], bi = p.b_i[c];
    const float m8sp = -8.0f * log1pf(expf(-p.lam[c]));
    float xm3, xm2, xm1, h;
    if (smp) { const float* sc = p.st_conv + (size_t)sidx * 3 * DA; xm3 = sc[c]; xm2 = sc[DA + c]; xm1 = sc[2 * DA + c]; h = FINAL ? p.st_h[(size_t)sidx * DA + c] : 0.f; }
    else if (cc == 0) { xm3 = xm2 = xm1 = 0.f; h = 0.f; }
    else { const bf16* zp = Z + (size_t)(row0 - 3) * DIN + DA + c; xm3 = bf2f(zp[0]); xm2 = bf2f(zp[DIN]); xm1 = bf2f(zp[2 * DIN]); h = 0.f;
        if (FINAL) { const float* ag = AGG + (size_t)(b * 32) * 2 * DA + c;
#pragma unroll 1
            for (int k0 = 0; k0 < cc; k0 += 16) { float Pk[16], Hk[16];
#pragma unroll
                for (int j = 0; j < 16; ++j) { const int kk = (k0 + j < cc) ? k0 + j : 0; Pk[j] = ag[(size_t)kk * 2 * DA]; Hk[j] = ag[(size_t)kk * 2 * DA + DA]; }
#pragma unroll
                for (int j = 0; j < 16; ++j) if (k0 + j < cc) h = Pk[j] * h + Hk[j]; } } }
    const bool first = !smp && cc == 0;
    float slog = 0.f;
    bf16* MIX = (bf16*)(p.ws + WS_MIX);
    const f32x4 ga = *(const f32x4*)(p.g_out_a + lane * 8), gb = *(const f32x4*)(p.g_out_a + lane * 8 + 4);
    unsigned short xr[16], gr[16];
    { const bf16* zr0 = Z + (size_t)row0 * DIN + c;
#pragma unroll
      for (int tt = 0; tt < 16; ++tt) { xr[tt] = zr0[(size_t)tt * DIN + DA]; gr[tt] = FINAL ? zr0[(size_t)tt * DIN] : (unsigned short)0; } }
#pragma unroll 1
    for (int sc = 0; sc < 4; ++sc) {
        float xc[16];
#pragma unroll
        for (int tt = 0; tt < 16; ++tt) { const float xin = bf2f(xr[tt]);
            const float v = cb + cw0 * xm3 + cw1 * xm2 + cw2 * xm1 + cw3 * xin; xm3 = xm2; xm2 = xm1; xm1 = xin; xc[tt] = v; XC[tt * 72 + lane] = (bf16)f2bf(v); }
        float gt[16];
#pragma unroll
        for (int tt = 0; tt < 16; ++tt) gt[tt] = bf2f(gr[tt]);
        if (sc < 3) { const bf16* zn = Z + (size_t)(row0 + (sc + 1) * 16) * DIN + c;
#pragma unroll
            for (int tt = 0; tt < 16; ++tt) { xr[tt] = zn[(size_t)tt * DIN + DA]; if (FINAL) gr[tt] = zn[(size_t)tt * DIN]; } }
        LDS_WAIT();
        const bf16x8 a0 = *(const LAS bf16x8*)(XC + (lane & 15) * 72 + (lane >> 4) * 8), a1 = *(const LAS bf16x8*)(XC + (lane & 15) * 72 + 32 + (lane >> 4) * 8);
#pragma unroll
        for (int nt = 0; nt < 4; ++nt) { pg8::f32x4 ar = {0.f, 0.f, 0.f, 0.f}, ai = {0.f, 0.f, 0.f, 0.f};
            const bf16x8 br0 = wfrag[nt * 64], br1 = wfrag[(4 + nt) * 64], bi0 = wfrag[(size_t)8 * 8 * 64 + nt * 64], bi1 = wfrag[(size_t)8 * 8 * 64 + (4 + nt) * 64];
            ar = __builtin_amdgcn_mfma_f32_16x16x32_bf16(a0, br0, ar, 0, 0, 0); ar = __builtin_amdgcn_mfma_f32_16x16x32_bf16(a1, br1, ar, 0, 0, 0);
            ai = __builtin_amdgcn_mfma_f32_16x16x32_bf16(a0, bi0, ai, 0, 0, 0); ai = __builtin_amdgcn_mfma_f32_16x16x32_bf16(a1, bi1, ai, 0, 0, 0);
#pragma unroll
            for (int r = 0; r < 4; ++r) { RB[((lane >> 4) * 4 + r) * 64 + nt * 16 + (lane & 15)] = ar[r]; IB[((lane >> 4) * 4 + r) * 64 + nt * 16 + (lane & 15)] = ai[r]; } }
        LDS_WAIT();
        if (FINAL && sc > 0) __syncthreads();
#pragma unroll
        for (int tt = 0; tt < 16; ++tt) {
            const float rg = sigmoidf_(RB[tt * 64 + lane] + br), ig = sigmoidf_(IB[tt * 64 + lane] + bi);
            const float la = m8sp * rg; const float a = __builtin_amdgcn_exp2f(1.4426950408889634f * la);
            const float x2 = la + la; const float ser = -x2 * (1.0f + x2 * (0.5f + x2 * (0.16666667f + x2 * (0.041666668f + x2 * 0.0083333338f))));
            const float om = x2 > -0.25f ? ser : 1.0f - a * a;
            float mult = __builtin_amdgcn_sqrtf(om); if (first && sc == 0 && tt == 0) mult = 1.0f;
            h = a * h + mult * (ig * xc[tt]); slog += la;
            if (FINAL) YS[tt * DA + c] = h * pg8::gelu_tanh(gt[tt]);
        }
        LDS_WAIT();
        if (FINAL) {
            __syncthreads();
#pragma unroll
            for (int tj = 0; tj < 2; ++tj) { const int t = wave * 2 + tj;
                const f32x4 va = *(const LAS f32x4*)(YS + t * DA + lane * 8), vb = *(const LAS f32x4*)(YS + t * DA + lane * 8 + 4);
                const float ss = wave_sum((va.x * va.x + va.y * va.y) + (va.z * va.z + va.w * va.w) + (vb.x * vb.x + vb.y * vb.y) + (vb.z * vb.z + vb.w * vb.w));
                const float rs = 1.0f / sqrtf(ss * (1.f / DA) + EPS);
                v4u o; o.x = pk2(va.x * rs * ga.x, va.y * rs * ga.y); o.y = pk2(va.z * rs * ga.z, va.w * rs * ga.w); o.z = pk2(vb.x * rs * gb.x, vb.y * rs * gb.y); o.w = pk2(vb.z * rs * gb.z, vb.w * rs * gb.w);
                *(v4u*)(MIX + (size_t)(row0 + sc * 16 + t) * D + lane * 8) = o; }
            LDS_WAIT();
        }
    }
    if (!FINAL) { AGG[(size_t)q * 2 * DA + c] = expf(slog); AGG[(size_t)q * 2 * DA + DA + c] = h; return; }
    if (smp || cc == 31) {
        float* oh = smp ? p.out + O_HS + (size_t)sidx * DA : p.out + O_HP + (size_t)b * DA; oh[c] = h;
        float* oc = smp ? p.out + O_CS + (size_t)sidx * 3 * DA : p.out + O_CP + (size_t)b * 3 * DA; oc[c] = xm3; oc[DA + c] = xm2; oc[2 * DA + c] = xm1;
    }
    __syncthreads();
}

constexpr int VP = 132;
constexpr int MB_GOB = 512 * VP * 2;
__device__ __forceinline__ void mixer_b_item(const P& p, LAS unsigned char* lds, int k, int wave, int lane) {
    asm volatile("" : "+v"(lane));
    const bool smp = k >= 128; const int sidx = k - 128; const int L = smp ? 64 : 128; const int row0 = smp ? MP + sidx * SSEQ : k * 128;
    const bf16* Z = (const bf16*)(p.ws + WS_Z);
    LAS bf16* VNt = (LAS bf16*)lds;
    LAS float* GOB = (LAS float*)(lds + MB_GOB);
    GOB[threadIdx.x] = p.g_out_b[threadIdx.x];
    const int RW = L / 8;
    {
    float gv[8], bv[8];
#pragma unroll
    for (int e = 0; e < 8; ++e) { gv[e] = p.g_v[e * 64 + lane]; bv[e] = p.b_v[e * 64 + lane]; }
#pragma unroll 1
    for (int jj = 0; jj < RW; jj += 4) { const int j0 = wave * RW + jj;
        float v[4][8]; float s[4];
#pragma unroll
        for (int r = 0; r < 4; ++r) { const bf16* zr = Z + (size_t)(row0 + j0 + r) * DIN + 3 * DA;
#pragma unroll
            for (int e = 0; e < 8; ++e) v[r][e] = bf2f(zr[e * 64 + lane]); }
#pragma unroll
        for (int r = 0; r < 4; ++r) { s[r] = 0.f;
#pragma unroll
            for (int e = 0; e < 8; ++e) s[r] += v[r][e]; }
        wave_sum_n<4>(s);
        float s2[4];
#pragma unroll
        for (int r = 0; r < 4; ++r) { const float mu = s[r] * (1.f / DB); s2[r] = 0.f;
#pragma unroll
            for (int e = 0; e < 8; ++e) { v[r][e] -= mu; s2[r] += v[r][e] * v[r][e]; } }
        wave_sum_n<4>(s2);
#pragma unroll
        for (int r = 0; r < 4; ++r) { const float rstd = 1.0f / sqrtf(s2[r] * (1.f / DB) + EPS); const int j = j0 + r;
#pragma unroll
            for (int e = 0; e < 8; ++e) { const float vn = v[r][e] * rstd * gv[e] + bv[e]; VNt[(e * 64 + lane) * VP + j] = (bf16)f2bf(vn);
                if (smp) p.out[O_VS + ((size_t)sidx * SSEQ + j) * DB + e * 64 + lane] = vn; } }
    }
    }
    __syncthreads();
    if (wave * 16 < L) {
        const int i0 = wave * 16, nks = (smp || i0 < 64) ? 2 : 4;
        int il = lane & 15, kg = lane >> 4; asm volatile("" : "+v"(il), "+v"(kg));
        const int row = row0 + i0 + il;
        bf16* MIX = (bf16*)(p.ws + WS_MIX);
        bf16x8 wf[2][4]; v2u uraw[4][8]; float bsv[4];
        const bf16x8* wsf = (const bf16x8*)(p.ws + WS_WSF) + (size_t)wave * 4 * 64 + lane;
#pragma unroll
        for (int hh = 0; hh < 4; ++hh) { bsv[hh] = p.b_s[hh * 128 + i0 + il];
#pragma unroll
            for (int dt = 0; dt < 8; ++dt) uraw[hh][dt] = *(const v2u*)(Z + (size_t)row * DIN + 2 * DA + hh * 128 + dt * 16 + kg * 4);
        }
#pragma unroll
        for (int ks = 0; ks < 4; ++ks) wf[0][ks] = wsf[ks * 64];
        float ss = 0.f, rs = 0.f;
#pragma unroll 1
        for (int pass = 0; pass < 2; ++pass) {
            bf16* mrow = MIX + (size_t)row * D + DA + kg * 4; unsigned gobo = (unsigned)(MB_GOB + kg * 16);
            asm volatile("" : "+v"(mrow), "+v"(gobo));
#pragma unroll
            for (int hh = 0; hh < 4; ++hh) {
#pragma unroll
                for (int ks = 0; ks < 4; ++ks) wf[(hh + 1) & 1][ks] = wsf[(size_t)(((hh + 1) & 3) * 8 * 4 + ks) * 64];
                unsigned vbase = (unsigned)(((hh * 128 + il) * VP + kg * 8) * 2);
                asm volatile("" : "+v"(vbase));
#pragma unroll
                for (int dt = 0; dt < 8; ++dt) { pg8::f32x4 a = {0.f, 0.f, 0.f, 0.f};
#pragma unroll
                    for (int ks = 0; ks < 4; ++ks) if (ks < nks) { const LAS bf16* vp = (const LAS bf16*)(lds + vbase) + (dt * 16) * VP + ks * 32;
                        typedef short s16x4 __attribute__((ext_vector_type(4)));
                        const s16x4 lo = *(const LAS s16x4*)vp, hi = *(const LAS s16x4*)(vp + 4);
                        const bf16x8 af = {lo[0], lo[1], lo[2], lo[3], hi[0], hi[1], hi[2], hi[3]};
                        a = __builtin_amdgcn_mfma_f32_16x16x32_bf16(af, wf[hh & 1][ks], a, 0, 0, 0); }
                    const v2u ur = uraw[hh][dt];
                    const pg8::f32x4 u4 = {__builtin_bit_cast(float, ur.x << 16), __builtin_bit_cast(float, ur.x & 0xffff0000u), __builtin_bit_cast(float, ur.y << 16), __builtin_bit_cast(float, ur.y & 0xffff0000u)};
                    const pg8::f32x4 yv = u4 * (a + bsv[hh]);
                    if (pass == 0) ss += (yv[0] * yv[0] + yv[1] * yv[1]) + (yv[2] * yv[2] + yv[3] * yv[3]);
                    else { const f32x4 g = *(const LAS f32x4*)(lds + gobo + (hh * 128 + dt * 16) * 4);
                        v2u o; o.x = pk2(yv[0] * rs * g.x, yv[1] * rs * g.y); o.y = pk2(yv[2] * rs * g.z, yv[3] * rs * g.w);
                        *(v2u*)(mrow + hh * 128 + dt * 16) = o; }
                    __builtin_amdgcn_sched_barrier(0);
                }
            }
            if (pass == 0) { ss += __shfl_xor(ss, 16); ss += __shfl_xor(ss, 32); rs = 1.0f / sqrtf(ss * (1.f / DB) + EPS); }
        }
    }
    __syncthreads();
}

#define XB_TMO      128
#define XB_XCNT(j)  (256  + 64 * (j))
#define XB_XSUB(j)  (1280 + 64 * (j))
#define XB_XGEN(j)  (2304 + 64 * (j))
#define XB_TOP      3328
#define XB_TOPGEN   3392
#define XCD_BAR_WORDS 3456
#define XB_SPIN_CAP (1u << 18)

__device__ __forceinline__ unsigned xb_ld(unsigned* p)              { return __hip_atomic_load(p, __ATOMIC_RELAXED, __HIP_MEMORY_SCOPE_AGENT); }
__device__ __forceinline__ unsigned xb_add(unsigned* p, unsigned v) { return __hip_atomic_fetch_add(p, v, __ATOMIC_RELAXED, __HIP_MEMORY_SCOPE_AGENT); }
__device__ __forceinline__ unsigned xb_xcc_id() { return (unsigned)__builtin_amdgcn_s_getreg((3 << 11) | 20) & 0xFu; }
#define XB_SPIN(cond, bar) do { unsigned _sp = 0; while (cond) { __builtin_amdgcn_s_sleep(1); \
    if ((++_sp & 255u) == 0u) { if (xb_ld(&(bar)[XB_TMO])) break; if (_sp > XB_SPIN_CAP) { atomicAdd(&(bar)[XB_TMO], 1u); break; } } } } while (0)

struct XcdBarrier {
    unsigned* bar; unsigned x;
    volatile LAS unsigned* st;
};

__device__ __forceinline__ XcdBarrier xcd_barrier_post(unsigned* bar, volatile LAS unsigned* st) {
    XcdBarrier b; b.bar = bar; b.x = xb_xcc_id(); b.st = st;
    if (threadIdx.x == 0) (void)xb_add(&bar[XB_XCNT(b.x)], 1u);
    return b;
}
__device__ __forceinline__ void xcd_barrier_complete(unsigned* bar, unsigned x, unsigned& nloc, unsigned& nx) {
    const unsigned G = gridDim.x * gridDim.y * gridDim.z;
    unsigned sum, cnt, mine, sp = 0u;
    for (;;) {
        sum = 0u; cnt = 0u; mine = 0u;
#pragma unroll
        for (unsigned j = 0; j < 16; ++j) { const unsigned c = xb_ld(&bar[XB_XCNT(j)]); sum += c; cnt += (c > 0u) ? 1u : 0u; mine = (j == x) ? c : mine; }
        if (sum == G) break;
        __builtin_amdgcn_s_sleep(1);
        if ((++sp & 255u) == 0u) { if (xb_ld(&bar[XB_TMO])) break; if (sp > XB_SPIN_CAP) { atomicAdd(&bar[XB_TMO], 1u); break; } }
    }
    nloc = mine > 0u ? mine : 1u; nx = cnt > 0u ? cnt : 1u;
}

__device__ __forceinline__ void xcd_barrier(const XcdBarrier& b) {
    asm volatile("s_waitcnt vmcnt(0)" ::: "memory");
    __syncthreads();
    if (threadIdx.x == 0) {
        unsigned* bar = b.bar;
        __builtin_amdgcn_s_waitcnt(0);
        unsigned nloc = b.st[0], nx = b.st[1];
        if (nloc == 0u) { xcd_barrier_complete(bar, b.x, nloc, nx); b.st[0] = nloc; b.st[1] = nx; }
        const unsigned old = xb_add(&bar[XB_XSUB(b.x)], 1u);
        const unsigned gen = old / nloc;
        if (old + 1u == (gen + 1u) * nloc) {
            __builtin_amdgcn_fence(__ATOMIC_RELEASE, "agent");
            asm volatile("s_waitcnt vmcnt(0)" ::: "memory");
            const unsigned og = xb_add(&bar[XB_TOP], 1u);
            const unsigned tg = og / nx;
            if (og + 1u == (tg + 1u) * nx) xb_add(&bar[XB_TOPGEN], 1u);
            else XB_SPIN(xb_ld(&bar[XB_TOPGEN]) == tg, bar);
            __builtin_amdgcn_fence(__ATOMIC_ACQUIRE, "agent");
            xb_add(&bar[XB_XGEN(b.x)], 1u);
            asm volatile("s_waitcnt vmcnt(0)" ::: "memory");
        } else {
            XB_SPIN(xb_ld(&bar[XB_XGEN(b.x)]) == gen, bar);
            __builtin_amdgcn_fence(__ATOMIC_ACQUIRE, "agent");
            asm volatile("s_waitcnt vmcnt(0)" ::: "memory");
        }
    }
    __syncthreads();
}

struct Args { const float* in[28]; float* out; unsigned char* ws; int ph_lo, ph_hi; };
constexpr int NPH = 10;
__global__ void __launch_bounds__(512, 2) fwd(Args args) {
    extern __shared__ __attribute__((aligned(16))) unsigned char lds_raw[];
    LAS unsigned char* lds = (LAS unsigned char*)lds_raw;
    const int tid = threadIdx.x, lane = tid & 63, wave = __builtin_amdgcn_readfirstlane(tid >> 6);
    const int G = gridDim.x, bx = blockIdx.x;
    const int gw = bx * 8 + wave, NGW = G * 8;
    P p;
    p.xp = args.in[0]; p.xs = args.in[1]; p.st_h = args.in[2]; p.st_conv = args.in[3]; p.st_ffn = args.in[4]; p.g_pre1 = args.in[5]; p.w_in = args.in[6]; p.w_conv_a = args.in[7]; p.b_conv_a = args.in[8];
    p.w_r = args.in[9]; p.b_r = args.in[10]; p.w_i = args.in[11]; p.b_i = args.in[12]; p.lam = args.in[13]; p.g_out_a = args.in[14]; p.g_v = args.in[15]; p.b_v = args.in[16]; p.w_s = args.in[17]; p.b_s = args.in[18];
    p.g_out_b = args.in[19]; p.w_o = args.in[20]; p.g_post1 = args.in[21]; p.g_pre2 = args.in[22]; p.w_up = args.in[23]; p.w_conv_f = args.in[24]; p.b_conv_f = args.in[25]; p.w_down = args.in[26]; p.g_post2 = args.in[27];
    p.out = args.out; p.ws = args.ws;
    unsigned char* ws = args.ws;
    bf16 *Wt_in = (bf16*)(ws + WS_WIN), *Wt_o = (bf16*)(ws + WS_WO), *Wt_up = (bf16*)(ws + WS_WUP), *Wt_dn = (bf16*)(ws + WS_WDN);
    bf16 *XN = (bf16*)(ws + WS_XN), *Zb = (bf16*)(ws + WS_Z), *MIX = (bf16*)(ws + WS_MIX), *HB = (bf16*)(ws + WS_HB), *XNB = (bf16*)(ws + WS_XNB), *UB = (bf16*)(ws + WS_UB);
    float* Fb = (float*)(ws + WS_F);
    const int lo = args.ph_lo, hi = args.ph_hi;
    volatile LAS unsigned* MISC = (volatile LAS unsigned*)(lds + LDS_BYTES - 64);
    if (tid < 16) MISC[tid] = 0u;
    __syncthreads();
    XcdBarrier bar = xcd_barrier_post((unsigned*)(ws + WS_CTL) + 1024, MISC);
#ifndef PHASE_MASK
#define PHASE_MASK 0x3ff
#endif
#define IN(k) ((((PHASE_MASK) >> (k)) & 1) && lo <= (k) && (k) < hi)
#ifndef SYNC_REPS
#define SYNC_REPS 1
#endif
#ifndef MIX_REPS
#define MIX_REPS 1
#endif
#ifndef REP_MASK
#define REP_MASK 0
#endif
#define PHASE(k) for (int r_ = 0; r_ < ((((REP_MASK) >> (k)) & 1) ? 2 : 1); ++r_) if (r_ && (xcd_barrier(bar), false)) {} else if (IN(k))
#define SEAM(k) do { if (IN(k) && IN((k) + 1)) { for (int r_ = 0; r_ < SYNC_REPS; ++r_) xcd_barrier(bar); } } while (0)

    PHASE(0) {
        LAS float* scr = (LAS float*)(lds + wave * 16384);
        constexpr int I_IN = (D / 64) * (DIN / 32), I_O = (D / 64) * (D / 32), I_UP = (D / 64) * (FF2 / 32), I_DN = (FF / 64) * (D / 32);
        for (int it = gw; it < I_IN + I_O + I_UP + I_DN; it += NGW) { int r = it;
            if (r < I_IN) { p0_transpose_item(p.w_in, D, DIN, Wt_in, false, scr, r, lane); continue; } r -= I_IN;
            if (r < I_O) { p0_transpose_item(p.w_o, D, D, Wt_o, false, scr, r, lane); continue; } r -= I_O;
            if (r < I_UP) { p0_transpose_item(p.w_up, D, FF2, Wt_up, true, scr, r, lane); continue; } r -= I_UP;
            p0_transpose_item(p.w_down, FF, D, Wt_dn, false, scr, r, lane); }
        for (int idx = bx * 512 + tid; idx < 2 * 8 * 8 * 64 * 8; idx += G * 512) { const int j = idx & 7, ln = (idx >> 3) & 63, f = (idx >> 9) & 7, hh = (idx >> 12) & 7, mat = idx >> 15;
            const int d = (f >> 2) * 32 + (ln >> 4) * 8 + j, e = (f & 3) * 16 + (ln & 15);
            ((bf16*)(ws + WS_WRF))[idx] = (bf16)f2bf((mat ? p.w_i : p.w_r)[(size_t)hh * 4096 + d * 64 + e]); }
        for (int idx = bx * 512 + tid; idx < 4 * 8 * 4 * 64 * 8; idx += G * 512) { const int j = idx & 7, ln = (idx >> 3) & 63, ks = (idx >> 9) & 3, it = (idx >> 11) & 7, hh = idx >> 14;
            ((bf16*)(ws + WS_WSF))[idx] = (bf16)f2bf(p.w_s[((size_t)hh * 128 + it * 16 + (ln & 15)) * 128 + ks * 32 + (ln >> 4) * 8 + j]); }
        for (int m0 = gw * 2; m0 < M; m0 += NGW * 2) rows_pre1<2>(p, m0, lane);
        __syncthreads();
    }
    SEAM(0);
    PHASE(1) { pg8::Gemm g{XN, Wt_in, M, DIN, D, D}; pg8::ComboOrder S; S.init(MP, DIN, D, G, bx, 64, 4, 4);
        pg8::EpiZ E{Zb, DIN, (float*)(ws + WS_ZP), (size_t)1024 * DIN};
        pg8::gemm_phase<pg8::EpiZ, pg8::ComboOrder, true, true>(lds, g, S, E); }
    SEAM(1);
    for (int rep_ = 0; rep_ < MIX_REPS; ++rep_) {
    PHASE(2) {
        for (int idx = bx * 512 + tid; idx < 1024 * (DIN / 8); idx += G * 512) {
            const f32x4* zp = (const f32x4*)(ws + WS_ZP) + (size_t)idx * 2; constexpr size_t SS = (size_t)1024 * DIN / 4;
            const f32x4 a = (zp[0] + zp[SS]) + (zp[2 * SS] + zp[3 * SS]), b2 = (zp[1] + zp[SS + 1]) + (zp[2 * SS + 1] + zp[3 * SS + 1]);
            v4u o; o.x = pk2(a.x, a.y); o.y = pk2(a.z, a.w); o.z = pk2(b2.x, b2.y); o.w = pk2(b2.z, b2.w);
            *((v4u*)(Zb + (size_t)MP * DIN) + idx) = o; }
        for (int it = bx; it < NB * 31; it += G) { const int q = (it / 31) * 32 + it % 31; mixer_a_item<false>(p, lds, q, wave, lane); } }
    SEAM(2);
    PHASE(3) { for (int it = bx; it < 272 + 144; it += G) { if (it < 272) mixer_a_item<true>(p, lds, it, wave, lane); else mixer_b_item(p, lds, it - 272, wave, lane); } }
    SEAM(3);
    }
    PHASE(4) { pg8::Gemm g{MIX, Wt_o, M, D, D, D}; pg8::ComboOrder S; S.init(MP, D, D, G, bx, 64, 4, 4);
        pg8::EpiF32 E{p.out + O_Y, D, nullptr, 64, (float*)(ws + WS_YP), (size_t)1024 * D};
        pg8::gemm_phase<pg8::EpiF32, pg8::ComboOrder, true, true>(lds, g, S, E); }
    SEAM(4);
    PHASE(5) { for (int m0 = gw * 2; m0 < M; m0 += NGW * 2) rows_post1<2>(p, m0, lane); }
    SEAM(5);
    PHASE(6) { pg8::Gemm g{XNB, Wt_up, 512, FF2, D, D}; pg8::StaticOrder S; S.init(512, FF2, D, G, bx);
        pg8::EpiBf16<0> E{UB, FF2, nullptr, 0, 0, 1.f};
        pg8::gemm_phase<pg8::EpiBf16<0>, pg8::StaticOrder, true, true>(lds, g, S, E); }
    SEAM(6);
    PHASE(7) { pg8::Gemm g{XN, Wt_up, M, FF2, D, D}; pg8::StaticOrder S; S.init(M, FF2, D, G, bx);
        pg8::EpiConvGeglu E{HB, UB, p.st_ffn, p.w_conv_f, p.b_conv_f, p.out + O_FP, p.out + O_FS};
        pg8::gemm_phase<pg8::EpiConvGeglu, pg8::StaticOrder, true, true>(lds, g, S, E); }
    SEAM(7);
    PHASE(8) { pg8::Gemm g{HB, Wt_dn, M, D, FF, FF}; pg8::ComboOrder S; S.init(MP, D, FF, G, bx, 64, 4, 8);
        pg8::EpiF32 E{Fb, D, nullptr, 64, (float*)(ws + WS_FP), (size_t)1024 * D};
        pg8::gemm_phase<pg8::EpiF32, pg8::ComboOrder, true, true>(lds, g, S, E); }
    SEAM(8);
    PHASE(9) { for (int m0 = gw * 2; m0 < M; m0 += NGW * 2) rows_post2<2>(p, m0, lane); }
#undef IN
#undef SEAM
}

extern "C" void kernel_launch(void* const* d_in, const int* in_sizes, int n_in, void* d_out, int out_size, void* d_ws, size_t ws_size, hipStream_t stream) {
    static int grid = 0;
    if (grid == 0) {
        if (n_in != 28 || (size_t)out_size != O_END || ws_size < WS_END) { fprintf(stderr, "kernel_launch: unexpected shapes: n_in %d out %d ws %zu\n", n_in, out_size, ws_size); grid = -1; return; }
        int dev = 0, cus = 0, per_cu = 0;
        if (hipGetDevice(&dev) != hipSuccess || hipDeviceGetAttribute(&cus, hipDeviceAttributeMultiprocessorCount, dev) != hipSuccess) { grid = -1; return; }
        if (hipFuncSetAttribute((const void*)fwd, hipFuncAttributeMaxDynamicSharedMemorySize, LDS_BYTES) != hipSuccess) { fprintf(stderr, "kernel_launch: hipFuncSetAttribute failed\n"); grid = -1; return; }
        if (hipOccupancyMaxActiveBlocksPerMultiprocessor(&per_cu, (const void*)fwd, 512, LDS_BYTES) != hipSuccess || per_cu < 1) { fprintf(stderr, "kernel_launch: occupancy query failed (%d)\n", per_cu); (void)hipGetLastError(); per_cu = 1; }
        grid = cus * 1;
        if (grid > 256) grid = 256;
    }
    if (grid < 0) return;
    if (hipMemsetAsync((char*)d_ws + WS_CTL, 0, CTL_ZERO_BYTES, stream) != hipSuccess) { fprintf(stderr, "kernel_launch: memset failed\n"); return; }
    Args a{};
    for (int i = 0; i < 28; ++i) a.in[i] = (const float*)d_in[i];
    a.out = (float*)d_out; a.ws = (unsigned char*)d_ws; a.ph_lo = 0; a.ph_hi = NPH;
    void* kargs[] = {&a};
    const hipError_t e = hipLaunchCooperativeKernel((const void*)fwd, dim3(grid), dim3(512), kargs, LDS_BYTES, stream);
    if (e != hipSuccess) fprintf(stderr, "kernel_launch: cooperative launch failed: %s (grid %d)\n", hipGetErrorString(e), grid);
}
```

```cpp
#include <hip/hip_runtime.h>
#include <cstdio>
#include <cstdint>
namespace pg8 {
#define PG8_LAS __attribute__((address_space(3)))
typedef unsigned short bf16_t;
typedef short bf16x8 __attribute__((ext_vector_type(8)));
typedef float f32x4 __attribute__((ext_vector_type(4)));
typedef unsigned u32x4 __attribute__((ext_vector_type(4)));
constexpr int BM = 256, BK = 64, HALF = 128, HTB = HALF * BK * 2  , STAGE_BYTES = 8 * HTB, NXCD = 8, WGM = 8;

__host__ __device__ __forceinline__ int lds_byte(int r, int c) { const int st = (r >> 4) * 2 + (c >> 5), rr = r & 15, cc = c & 31, ob = rr * 64 + cc * 2; return st * 1024 + (ob ^ (((ob >> 9) & 1) << 5)); }
__host__ __device__ __forceinline__ void stage_rc(int b, int& R, int& C) { const int st = b / 1024, sb = b % 1024, swz = sb ^ (((sb >> 9) & 1) << 5); R = (st >> 1) * 16 + swz / 64; C = (st & 1) * 32 + (swz % 64) / 2; }
__host__ __device__ __forceinline__ int perm32(int rho) { const int n = rho >> 4, i = rho & 15; return 8 * (i >> 2) + 4 * n + (i & 3); }

struct Unit { int pm, pn, k0, ks, nt; };
struct Gemm { const bf16_t* A; const bf16_t* Bt; int M, N, K, ld; };

struct StaticOrder {
    int nM, nN, nwg, G, c, nt;
    __host__ __device__ void init(int M, int N, int Kc, int G_, int c_) { nM = M / BM; nN = N / BM; nwg = nM * nN; G = G_; c = c_; nt = Kc / BK; }
    __host__ __device__ bool next(int i, Unit& u) const {
        const long L = (long)i * G + c; if (L >= nwg) return false;
        int wgid = (int)L; { const int q = nwg / NXCD, r = nwg % NXCD, xcd = wgid % NXCD, off = wgid / NXCD; wgid = (xcd < r ? xcd * (q + 1) : r * (q + 1) + (xcd - r) * q) + off; }
        const int nig = WGM * nN, gid = wgid / nig, fm = gid * WGM, gsz = (nM - fm) < WGM ? (nM - fm) : WGM;
        u.pm = fm + ((wgid % nig) % gsz); u.pn = (wgid % nig) / gsz; u.k0 = 0; u.ks = 0; u.nt = nt; return true;
    }
    __device__ __forceinline__ void a_ready(const Unit&) const {}
    __device__ __forceinline__ void done(const Unit&) const {}
};

struct ComboOrder {
    StaticOrder st; int nst, pm0, nP, nN2, nS, ntS;
    __host__ __device__ void init(int M, int N, int K, int G_, int c_, int pm0_, int nP_, int nS_) { st.init(M, N, K, G_, c_); nst = c_ < st.nwg ? (st.nwg - c_ + G_ - 1) / G_ : 0;
        pm0 = pm0_; nP = nP_; nN2 = N / BM; nS = nS_; ntS = K / BK / nS_; }
    __host__ __device__ bool next(int i, Unit& u) const {
        if (i < nst) return st.next(i, u);
        const int c = st.c; if (i > nst || c >= nP * nN2 * nS) return false;
        u.ks = c % nS; u.pn = (c / nS) % nN2; u.pm = pm0 + c / (nS * nN2); u.k0 = u.ks * ntS * BK; u.nt = ntS; return true;
    }
    __device__ __forceinline__ void a_ready(const Unit&) const {}
    __device__ __forceinline__ void done(const Unit&) const {}
};
__device__ __forceinline__ unsigned cvt_pk_bf16(float lo, float hi) { unsigned r; asm volatile("v_cvt_pk_bf16_f32 %0, %1, %2" : "=v"(r) : "v"(lo), "v"(hi)); return r; }
typedef float f32x2 __attribute__((ext_vector_type(2)));
__device__ __forceinline__ f32x2 gelu_pk(f32x2 v) {
    const f32x2 av = __builtin_elementwise_abs(v), d = av * 0.2316418882f + 1.0f;
    f32x2 t; t.x = __builtin_amdgcn_rcpf(d.x); t.y = __builtin_amdgcn_rcpf(d.y);
    f32x2 q = t * 0.5307027145f + (-0.7265760135f); q = q * t + 0.7107068705f; q = q * t + (-0.142248368f); q = q * t + 0.127414796f; q = q * t;
    const f32x2 s = (v * v) * (-0.72134752044f);
    f32x2 e; e.x = __builtin_amdgcn_exp2f(s.x); e.y = __builtin_amdgcn_exp2f(s.y);
    const f32x2 m = v * (q * e), r = v - m;
    f32x2 o; o.x = v.x < 0.f ? m.x : r.x; o.y = v.y < 0.f ? m.y : r.y; return o;
}

template <int ACT  > struct EpiBf16 {
    static constexpr bool PERM = true, AFTER_DRAIN = false; static_assert(ACT == 0 || ACT == 1, "EpiBf16: ACT is 0 (none) or 1 (gelu_pk)");
    bf16_t* O; int ldc; const float* bias; int split_cols; size_t split_stride; float scale0;
    __device__ __forceinline__ void operator()(const f32x4 (&acc)[2][2][4][2], const Unit& u, int wr, int wc, int fr, int fq) const {
        const int row0 = u.pm * BM + wr * 64 + fr; int colt = u.pn * BM; bf16_t* base = O;
        float sc = 1.f; if (split_cols) { const int t = colt / split_cols; base += (size_t)t * split_stride; colt -= t * split_cols; if (t == 0) sc = scale0; }
        const int col0 = colt + wc * 32 + 8 * fq, bcol0 = u.pn * BM + wc * 32 + 8 * fq;
        f32x4 bv[2][2];
#pragma unroll
        for (int bj = 0; bj < 2; ++bj)
#pragma unroll
            for (int n = 0; n < 2; ++n) bv[bj][n] = bias ? *(const f32x4*)(bias + bcol0 + bj * HALF + 4 * n) : (f32x4){0.f, 0.f, 0.f, 0.f};
#pragma unroll
        for (int ai = 0; ai < 2; ++ai)
#pragma unroll
            for (int m = 0; m < 4; ++m) { bf16_t* rowp = base + (size_t)(row0 + ai * HALF + m * 16) * ldc + col0;
#pragma unroll
                for (int bj = 0; bj < 2; ++bj) { f32x4 v0 = acc[ai][bj][m][0] + bv[bj][0], v1 = acc[ai][bj][m][1] + bv[bj][1];
                    if (ACT == 1) { f32x2 a = gelu_pk((f32x2){v0[0], v0[1]}), b = gelu_pk((f32x2){v0[2], v0[3]}), c = gelu_pk((f32x2){v1[0], v1[1]}), d = gelu_pk((f32x2){v1[2], v1[3]});
                        v0 = (f32x4){a.x, a.y, b.x, b.y}; v1 = (f32x4){c.x, c.y, d.x, d.y}; }
                    v0 = v0 * sc; v1 = v1 * sc; u32x4 w; w.x = cvt_pk_bf16(v0[0], v0[1]); w.y = cvt_pk_bf16(v0[2], v0[3]); w.z = cvt_pk_bf16(v1[0], v1[1]); w.w = cvt_pk_bf16(v1[2], v1[3]);
                    *(u32x4*)(rowp + bj * HALF) = w; } }
    }
};
struct EpiF32 {
    static constexpr bool PERM = false, AFTER_DRAIN = false;
    float* C; int ldc; const float* bias; int pm0; float* C1; size_t ks_stride;
    __device__ __forceinline__ void operator()(const f32x4 (&acc)[2][2][4][2], const Unit& u, int wr, int wc, int fr, int fq) const {
        const bool sp = u.pm >= pm0; const int row0 = (sp ? u.pm - pm0 : u.pm) * BM + wr * 64 + fr, col0 = u.pn * BM + wc * 32 + 4 * fq; float* C = sp ? C1 + (size_t)u.ks * ks_stride : this->C;
        f32x4 bv[2][2];
#pragma unroll
        for (int bj = 0; bj < 2; ++bj)
#pragma unroll
            for (int n = 0; n < 2; ++n) bv[bj][n] = bias ? *(const f32x4*)(bias + col0 + bj * HALF + n * 16) : (f32x4){0.f, 0.f, 0.f, 0.f};
#pragma unroll
        for (int ai = 0; ai < 2; ++ai)
#pragma unroll
            for (int m = 0; m < 4; ++m) { float* rowp = C + (size_t)(row0 + ai * HALF + m * 16) * ldc + col0;
#pragma unroll
                for (int bj = 0; bj < 2; ++bj)
#pragma unroll
                    for (int n = 0; n < 2; ++n) *(f32x4*)(rowp + bj * HALF + n * 16) = acc[ai][bj][m][n] + bv[bj][n]; }
    }
};
__device__ __forceinline__ float dpp_shr1(float old, float src) { return __builtin_bit_cast(float, __builtin_amdgcn_update_dpp(__builtin_bit_cast(int, old), __builtin_bit_cast(int, src), 0x111, 0xf, 0xf, false)); }
__device__ __forceinline__ float dpp_shr2(float old, float src) { return __builtin_bit_cast(float, __builtin_amdgcn_update_dpp(__builtin_bit_cast(int, old), __builtin_bit_cast(int, src), 0x112, 0xf, 0xf, false)); }
__device__ __forceinline__ float dpp_ror1(float src) { return __builtin_bit_cast(float, __builtin_amdgcn_update_dpp(0, __builtin_bit_cast(int, src), 0x121, 0xf, 0xf, false)); }
__device__ __forceinline__ float dpp_ror2(float src) { return __builtin_bit_cast(float, __builtin_amdgcn_update_dpp(0, __builtin_bit_cast(int, src), 0x122, 0xf, 0xf, false)); }
__device__ __forceinline__ float gelu_tanh(float x) {
    const float t = x * x, inner = x * (2.302208198f + 0.102943240f * t);
    return x * __builtin_amdgcn_rcpf(1.0f + __builtin_amdgcn_exp2f(-inner));
}
__device__ __forceinline__ f32x4 bf4_to_f4(const bf16_t* p) { const unsigned long long w = *(const unsigned long long*)p;
    return (f32x4){__builtin_bit_cast(float, (unsigned)(w << 16)), __builtin_bit_cast(float, (unsigned)w & 0xffff0000u), __builtin_bit_cast(float, (unsigned)(w >> 32) << 16), __builtin_bit_cast(float, (unsigned)(w >> 32) & 0xffff0000u)}; }

struct EpiConvGeglu {
    static constexpr bool PERM = true, AFTER_DRAIN = false;
    bf16_t* HB;
    const bf16_t* UB;
    const float* state;
    const float* wcv;
    const float* bcv;
    float* out_p;
    float* out_s;
    __device__ __forceinline__ void operator()(const f32x4 (&acc)[2][2][4][2], const Unit& u, int wr, int wc, int fr, int fq) const {
        const int cgb = u.pn * 128 + wc * 32 + 8 * fq;
        const int npb = u.pn * 256 + wc * 32 + 8 * fq;
#pragma unroll
        for (int n = 0; n < 2; ++n) {
            const int cg = cgb + 4 * n;
            const f32x4 w0g = *(const f32x4*)(wcv + cg), w1g = *(const f32x4*)(wcv + 6144 + cg), w2g = *(const f32x4*)(wcv + 12288 + cg), bg = *(const f32x4*)(bcv + cg);
            const f32x4 w0v = *(const f32x4*)(wcv + 3072 + cg), w1v = *(const f32x4*)(wcv + 6144 + 3072 + cg), w2v = *(const f32x4*)(wcv + 12288 + 3072 + cg), bv = *(const f32x4*)(bcv + 3072 + cg);
#pragma unroll
            for (int ai = 0; ai < 2; ++ai) {
                const int r0 = u.pm * BM + ai * HALF + wr * 64;
                f32x4 c1g, c2g, c1v, c2v;
                if (r0 >= 16384) { const float* st = state + (size_t)((r0 - 16384) >> 6) * 2 * 6144;
                    c2g = *(const f32x4*)(st + cg); c1g = *(const f32x4*)(st + 6144 + cg); c2v = *(const f32x4*)(st + 3072 + cg); c1v = *(const f32x4*)(st + 6144 + 3072 + cg); }
                else if ((r0 & 2047) == 0) { c1g = c2g = c1v = c2v = (f32x4){0.f, 0.f, 0.f, 0.f}; }
                else { const bf16_t* ub = UB + (size_t)(2 * (r0 >> 6)) * 6144 + npb + 4 * n;
                    c2g = bf4_to_f4(ub); c1g = bf4_to_f4(ub + 6144); c2v = bf4_to_f4(ub + 128); c1v = bf4_to_f4(ub + 6144 + 128); }
#pragma unroll
                for (int m = 0; m < 4; ++m) {
                    const f32x4 xg = acc[ai][0][m][n], xv = acc[ai][1][m][n];
                    f32x4 o1g, o2g, o1v, o2v;
                    if (m == 0) { o1g = c1g; o1v = c1v; o2g = (fr == 0) ? c2g : c1g; o2v = (fr == 0) ? c2v : c1v; }
                    else { const f32x4 pg = acc[ai][0][m > 0 ? m - 1 : 0][n], pv = acc[ai][1][m > 0 ? m - 1 : 0][n];
#pragma unroll
                        for (int e = 0; e < 4; ++e) { o1g[e] = dpp_ror1(pg[e]); o2g[e] = dpp_ror2(pg[e]); o1v[e] = dpp_ror1(pv[e]); o2v[e] = dpp_ror2(pv[e]); } }
                    float res[4];
#pragma unroll
                    for (int e = 0; e < 4; ++e) {
                        const float g1 = dpp_shr1(o1g[e], xg[e]), g2 = dpp_shr2(o2g[e], xg[e]);
                        const float v1 = dpp_shr1(o1v[e], xv[e]), v2 = dpp_shr2(o2v[e], xv[e]);
                        const float cgv = bg[e] + w0g[e] * g2 + w1g[e] * g1 + w2g[e] * xg[e];
                        const float cvv = bv[e] + w0v[e] * v2 + w1v[e] * v1 + w2v[e] * xv[e];
                        res[e] = gelu_tanh(cgv) * cvv;
                    }
                    typedef unsigned u32x2v __attribute__((ext_vector_type(2)));
                    u32x2v w; w.x = cvt_pk_bf16(res[0], res[1]); w.y = cvt_pk_bf16(res[2], res[3]);
                    *(u32x2v*)(HB + (size_t)(r0 + 16 * m + fr) * 3072 + cg) = w;
                }
                const bool smp = r0 >= 16384;
                if ((smp || (((r0 + 64) & 2047) == 0)) && fr >= 14) {
                    float* o = (smp ? out_s + (size_t)((r0 - 16384) >> 6) * 2 * 6144 : out_p + (size_t)(r0 >> 11) * 2 * 6144) + (fr - 14) * 6144;
                    *(f32x4*)(o + cg) = acc[ai][0][3][n]; *(f32x4*)(o + 3072 + cg) = acc[ai][1][3][n];
                }
            }
        }
    }
};

struct EpiZ {
    static constexpr bool PERM = true, AFTER_DRAIN = false;
    bf16_t* O; int ldc; float* C1; size_t ks_stride;
    __device__ __forceinline__ void operator()(const f32x4 (&acc)[2][2][4][2], const Unit& u, int wr, int wc, int fr, int fq) const {
        const int col0 = u.pn * BM + wc * 32 + 8 * fq;
        if (u.pm < 64) { const int row0 = u.pm * BM + wr * 64 + fr;
#pragma unroll
            for (int ai = 0; ai < 2; ++ai)
#pragma unroll
                for (int m = 0; m < 4; ++m) { bf16_t* rowp = O + (size_t)(row0 + ai * HALF + m * 16) * ldc + col0;
#pragma unroll
                    for (int bj = 0; bj < 2; ++bj) { const f32x4 v0 = acc[ai][bj][m][0], v1 = acc[ai][bj][m][1];
                        u32x4 w; w.x = cvt_pk_bf16(v0[0], v0[1]); w.y = cvt_pk_bf16(v0[2], v0[3]); w.z = cvt_pk_bf16(v1[0], v1[1]); w.w = cvt_pk_bf16(v1[2], v1[3]);
                        *(u32x4*)(rowp + bj * HALF) = w; } }
        } else { float* C = C1 + (size_t)u.ks * ks_stride; const int row0 = (u.pm - 64) * BM + wr * 64 + fr;
#pragma unroll
            for (int ai = 0; ai < 2; ++ai)
#pragma unroll
                for (int m = 0; m < 4; ++m) { float* rowp = C + (size_t)(row0 + ai * HALF + m * 16) * ldc + col0;
#pragma unroll
                    for (int bj = 0; bj < 2; ++bj) { *(f32x4*)(rowp + bj * HALF) = acc[ai][bj][m][0]; *(f32x4*)(rowp + bj * HALF + 4) = acc[ai][bj][m][1]; } }
        }
    }
};
template <class Epi, class Sched, bool ALIGN_EPI = false, bool SP2 = false>
__device__ __forceinline__ void gemm_phase(PG8_LAS unsigned char* lds, const Gemm g, const Sched& S, const Epi& E) {
    int tid_ = threadIdx.x; asm volatile("" : "+v"(tid_));
    const int tid = tid_, wid = __builtin_amdgcn_readfirstlane(tid >> 6), lane = tid & 63, wr = wid >> 2, wc = wid & 3, fr = lane & 15, fq = lane >> 4;
    const int K = g.ld;
    unsigned voffA[2], voffB[2];
#pragma unroll
    for (int i = 0; i < 2; ++i) { int R, C; stage_rc(tid * 16 + i * 8192, R, C); const int Rb = Epi::PERM ? ((R & ~31) + perm32(R & 31)) : R;
        voffA[i] = (unsigned)(R * K + C) * 2u; voffB[i] = (unsigned)(Rb * K + C) * 2u; }
    const size_t kstep = (size_t)(BK * 2);
    const size_t hstep = (size_t)HALF * K * 2;
    const size_t tstep = 2 * hstep;
    const unsigned ldsw = (unsigned)wid * 1024u;
    const int aoff = lds_byte(wr * 64 + fr, fq * 8), boff = lds_byte(wc * 32 + fr, fq * 8);
#define PG8_SA(b, h) (((b) * 2 + (h)) * HTB)
#define PG8_SB(b, h) ((4 + (b) * 2 + (h)) * HTB)
#define PG8_STAGE(bufoff, gbase, voff) do { _Pragma("unroll") for (int _i = 0; _i < 2; ++_i) \
        __builtin_amdgcn_global_load_lds((const unsigned*)((const char*)(gbase) + (voff)[_i]), (PG8_LAS unsigned*)(lds + (bufoff) + ldsw + _i * 8192), 16, 0, 0); } while (0)
#define PG8_LDA(dst, b, h) do { _Pragma("unroll") for (int m = 0; m < 4; ++m) _Pragma("unroll") for (int k = 0; k < 2; ++k) dst[m][k] = *(const PG8_LAS bf16x8*)(lds + PG8_SA(b, h) + aoff + m * 2048 + k * 1024); } while (0)
#define PG8_LDB(dst, b, h) do { _Pragma("unroll") for (int n = 0; n < 2; ++n) _Pragma("unroll") for (int k = 0; k < 2; ++k) dst[n][k] = *(const PG8_LAS bf16x8*)(lds + PG8_SB(b, h) + boff + n * 2048 + k * 1024); } while (0)
#define PG8_MMA(ai, bj, At, Bt) do { __builtin_amdgcn_s_setprio(1); _Pragma("unroll") for (int m = 0; m < 4; ++m) _Pragma("unroll") for (int n = 0; n < 2; ++n) _Pragma("unroll") for (int k = 0; k < 2; ++k) \
        acc[ai][bj][m][n] = __builtin_amdgcn_mfma_f32_16x16x32_bf16(Bt[n][k], At[m][k], acc[ai][bj][m][n], 0, 0, 0); __builtin_amdgcn_s_setprio(0); } while (0)
#define PG8_WAIT_V(n) asm volatile("s_waitcnt vmcnt(" #n ")" ::: "memory")
#define PG8_WAIT_L(n) asm volatile("s_waitcnt lgkmcnt(" #n ")" ::: "memory")
#define PG8_BAR __builtin_amdgcn_s_barrier()
#define PG8_SCHED __builtin_amdgcn_sched_barrier(0)
    Unit cur, nxt; int ui = 0;
    if (!S.next(0, cur)) return;
    f32x4 acc[2][2][4][2];
#pragma unroll
    for (int a = 0; a < 2; ++a)
#pragma unroll
        for (int b = 0; b < 2; ++b)
#pragma unroll
            for (int m = 0; m < 4; ++m)
#pragma unroll
                for (int n = 0; n < 2; ++n) acc[a][b][m][n] = (f32x4){0.f, 0.f, 0.f, 0.f};
    bf16x8 At[4][2], B0[2][2], B1[2][2];
    const char* cA = (const char*)g.A + (size_t)cur.pm * tstep + (size_t)cur.k0 * 2; const char* cB = (const char*)g.Bt + (size_t)cur.pn * tstep + (size_t)cur.k0 * 2;
    S.a_ready(cur);
    if constexpr (SP2) {
        PG8_STAGE(PG8_SB(0, 0), cB, voffB); PG8_STAGE(PG8_SB(0, 1), cB + hstep, voffB); PG8_STAGE(PG8_SA(0, 0), cA, voffA); PG8_STAGE(PG8_SA(0, 1), cA + hstep, voffA);
        if (wr == 1) PG8_BAR;
        PG8_WAIT_V(2); PG8_BAR;
        PG8_STAGE(PG8_SB(1, 0), cB + kstep, voffB); PG8_STAGE(PG8_SA(1, 0), cA + kstep, voffA); PG8_STAGE(PG8_SB(1, 1), cB + hstep + kstep, voffB);
        PG8_WAIT_V(6); PG8_BAR;
    } else {
        PG8_STAGE(PG8_SB(0, 0), cB, voffB); PG8_STAGE(PG8_SA(0, 0), cA, voffA); PG8_STAGE(PG8_SB(0, 1), cB + hstep, voffB); PG8_STAGE(PG8_SA(0, 1), cA + hstep, voffA);
        if (wr == 1) PG8_BAR;
        PG8_WAIT_V(4); PG8_BAR;
        PG8_STAGE(PG8_SB(1, 0), cB + kstep, voffB); PG8_STAGE(PG8_SA(1, 0), cA + kstep, voffA); PG8_STAGE(PG8_SB(1, 1), cB + hstep + kstep, voffB);
        PG8_WAIT_V(6); PG8_BAR;
    }
    for (;;) {
        const bool has_next = S.next(ui + 1, nxt);
        const char* nA = has_next ? (const char*)g.A + (size_t)nxt.pm * tstep + (size_t)nxt.k0 * 2 : cA; const char* nB = has_next ? (const char*)g.Bt + (size_t)nxt.pn * tstep + (size_t)nxt.k0 * 2 : cB;
        const int nt = cur.nt;
        for (int t = 0; t < nt; t += 2) {
            const bool last = (t == nt - 2);
            const char* a1 = cA + (size_t)(t + 1) * kstep;
            const char* a2 = last ? nA : cA + (size_t)(t + 2) * kstep; const char* b2 = last ? nB : cB + (size_t)(t + 2) * kstep;
            const char* a3 = a2 + kstep; const char* b3 = b2 + kstep;
            if (last && has_next) S.a_ready(nxt);
            if constexpr (SP2) {
            PG8_LDB(B0, 0, 0); PG8_LDB(B1, 0, 1); PG8_SCHED; PG8_LDA(At, 0, 0); PG8_STAGE(PG8_SA(1, 1), a1 + hstep, voffA);
            PG8_WAIT_V(8); PG8_WAIT_L(0); PG8_BAR; PG8_MMA(0, 0, At, B0); PG8_MMA(0, 1, At, B1); PG8_BAR; PG8_SCHED;
            PG8_LDA(At, 0, 1); PG8_STAGE(PG8_SB(0, 0), b2, voffB); PG8_STAGE(PG8_SB(0, 1), b2 + hstep, voffB); PG8_STAGE(PG8_SA(0, 0), a2, voffA);
            PG8_WAIT_V(8); PG8_WAIT_L(0); PG8_BAR; PG8_MMA(1, 0, At, B0); PG8_MMA(1, 1, At, B1); PG8_BAR; PG8_SCHED;
            PG8_LDB(B0, 1, 0); PG8_LDB(B1, 1, 1); PG8_SCHED; PG8_LDA(At, 1, 0); PG8_STAGE(PG8_SA(0, 1), a2 + hstep, voffA);
            PG8_WAIT_V(8); PG8_WAIT_L(0); PG8_BAR; PG8_MMA(0, 0, At, B0); PG8_MMA(0, 1, At, B1); PG8_BAR; PG8_SCHED;
            PG8_LDA(At, 1, 1); PG8_STAGE(PG8_SB(1, 0), b3, voffB); PG8_STAGE(PG8_SB(1, 1), b3 + hstep, voffB); PG8_STAGE(PG8_SA(1, 0), a3, voffA);
            PG8_WAIT_V(8); PG8_WAIT_L(0); PG8_BAR; PG8_MMA(1, 0, At, B0); PG8_MMA(1, 1, At, B1); PG8_BAR; PG8_SCHED;
            } else {
            PG8_LDB(B0, 0, 0); PG8_SCHED; PG8_LDA(At, 0, 0); PG8_STAGE(PG8_SA(1, 1), a1 + hstep, voffA);
            PG8_WAIT_L(8); PG8_BAR; PG8_WAIT_L(0); PG8_MMA(0, 0, At, B0); PG8_BAR; PG8_SCHED;
            PG8_LDB(B1, 0, 1); PG8_STAGE(PG8_SB(0, 0), b2, voffB);
            PG8_BAR; PG8_WAIT_L(0); PG8_MMA(0, 1, At, B1); PG8_BAR;
            PG8_LDA(At, 0, 1); PG8_STAGE(PG8_SA(0, 0), a2, voffA);
            PG8_BAR; PG8_WAIT_L(0); PG8_MMA(1, 0, At, B0); PG8_BAR; PG8_SCHED;
            PG8_STAGE(PG8_SB(0, 1), b2 + hstep, voffB);
            PG8_WAIT_V(6); PG8_BAR; PG8_MMA(1, 1, At, B1); PG8_BAR;
            PG8_LDB(B0, 1, 0); PG8_SCHED; PG8_LDA(At, 1, 0); PG8_STAGE(PG8_SA(0, 1), a2 + hstep, voffA);
            PG8_WAIT_L(8); PG8_BAR; PG8_WAIT_L(0); PG8_MMA(0, 0, At, B0); PG8_BAR; PG8_SCHED;
            PG8_LDB(B1, 1, 1); PG8_STAGE(PG8_SB(1, 0), b3, voffB);
            PG8_BAR; PG8_WAIT_L(0); PG8_MMA(0, 1, At, B1); PG8_BAR;
            PG8_LDA(At, 1, 1); PG8_STAGE(PG8_SA(1, 0), a3, voffA);
            PG8_BAR; PG8_WAIT_L(0); PG8_MMA(1, 0, At, B0); PG8_BAR; PG8_SCHED;
            PG8_STAGE(PG8_SB(1, 1), b3 + hstep, voffB);
            PG8_WAIT_V(6); PG8_BAR; PG8_MMA(1, 1, At, B1); PG8_BAR;
            }
        }
        if constexpr (ALIGN_EPI) { if (wr == 0) PG8_BAR; }
        if constexpr (!Epi::AFTER_DRAIN) { E(acc, cur, wr, wc, fr, fq); S.done(cur); }
        if (!has_next) break;
#pragma unroll
        for (int a = 0; a < 2; ++a)
#pragma unroll
            for (int b = 0; b < 2; ++b)
#pragma unroll
                for (int m = 0; m < 4; ++m)
#pragma unroll
                    for (int n = 0; n < 2; ++n) acc[a][b][m][n] = (f32x4){0.f, 0.f, 0.f, 0.f};
        cur = nxt; cA = nA; cB = nB; ++ui;
        if constexpr (ALIGN_EPI) { if (wr == 1) PG8_BAR; }
    }
    PG8_WAIT_V(0);
    if constexpr (!ALIGN_EPI) { if (wr == 0) PG8_BAR; }
    PG8_BAR;
    if constexpr (Epi::AFTER_DRAIN) { E.fused(acc, cur, wr, wc, fr, fq, lds, wid, lane); S.done(cur); }
#undef PG8_SA
#undef PG8_SB
#undef PG8_STAGE
#undef PG8_LDA
#undef PG8_LDB
#undef PG8_MMA
#undef PG8_WAIT_V
#undef PG8_WAIT_L
#undef PG8_BAR
#undef PG8_SCHED
}
}

constexpr int D = 1024, NB = 8, SEQ = 2048, NS = 16, SSEQ = 64, MP = NB * SEQ, M = MP + NS * SSEQ;
constexpr int DA = 512, DB = 512, DIN = 2048, FF = 3072, FF2 = 6144;
constexpr float EPS = 1e-6f;
constexpr size_t O_Y = 0, O_HP = (size_t)M * D, O_CP = O_HP + NB * DA, O_FP = O_CP + NB * 3 * DA, O_HS = O_FP + NB * 2 * FF2, O_CS = O_HS + NS * DA, O_FS = O_CS + NS * 3 * DA, O_VS = O_FS + NS * 2 * FF2,
                 O_END = O_VS + (size_t)NS * SSEQ * DB;
constexpr size_t MiB = 1u << 20;
constexpr size_t WS_CTL = 0, CTL_ZERO_BYTES = 65536;
constexpr size_t WS_WIN = 2 * MiB, WS_WO = 6 * MiB, WS_WUP = 8 * MiB, WS_WDN = 20 * MiB, WS_XN = 26 * MiB, WS_Z = 60 * MiB, WS_MIX = 128 * MiB, WS_HB = 60 * MiB, WS_F = 162 * MiB,
                 WS_XNB = 230 * MiB, WS_UB = 231 * MiB, WS_AGG = 237 * MiB, WS_WRF = 238 * MiB, WS_WSF = 238 * MiB + 262144  , WS_END = 239 * MiB,
                 WS_ZP = 162 * MiB  , WS_YP = 162 * MiB  ,
                 WS_FP = 26 * MiB  , WS_UBP = 162 * MiB  ;
constexpr int LDS_BYTES = 147456;

#define GAS __attribute__((address_space(1)))
#define LAS __attribute__((address_space(3)))
typedef unsigned short bf16;
typedef float f32x4 __attribute__((ext_vector_type(4)));
typedef short bf16x8 __attribute__((ext_vector_type(8)));
typedef unsigned v4u __attribute__((ext_vector_type(4)));
typedef unsigned v2u __attribute__((ext_vector_type(2)));
#define LDS_WAIT() asm volatile("s_waitcnt lgkmcnt(0)" ::: "memory")

__device__ __forceinline__ unsigned f2bf(float f) { unsigned u = __builtin_bit_cast(unsigned, f); return (u + 0x7fffu + ((u >> 16) & 1u)) >> 16; }
__device__ __forceinline__ unsigned pk2(float lo, float hi) { return f2bf(lo) | (f2bf(hi) << 16); }
__device__ __forceinline__ float bf2f(bf16 b) { return __builtin_bit_cast(float, (unsigned)b << 16); }
template <int CTRL> __device__ __forceinline__ float dppf(float v) { return __builtin_bit_cast(float, __builtin_amdgcn_update_dpp(0, __builtin_bit_cast(int, v), CTRL, 0xf, 0xf, true)); }
__device__ __forceinline__ float wave_sum(float v) {
    v += dppf<0xB1>(v); v += dppf<0x4E>(v); v += dppf<0x141>(v); v += dppf<0x140>(v);
    const float r0 = __builtin_bit_cast(float, __builtin_amdgcn_readlane(__builtin_bit_cast(int, v), 0)), r1 = __builtin_bit_cast(float, __builtin_amdgcn_readlane(__builtin_bit_cast(int, v), 16));
    const float r2 = __builtin_bit_cast(float, __builtin_amdgcn_readlane(__builtin_bit_cast(int, v), 32)), r3 = __builtin_bit_cast(float, __builtin_amdgcn_readlane(__builtin_bit_cast(int, v), 48));
    return (r0 + r1) + (r2 + r3);
}
__device__ __forceinline__ float sigmoidf_(float z) { return __builtin_amdgcn_rcpf(1.0f + __builtin_amdgcn_exp2f(-1.4426950408889634f * z)); }

__device__ __forceinline__ void p0_transpose_item(const float* W, int K, int N, bf16* WT, bool up_perm, LAS float* scr, int item, int lane) {
    const int nblk = N / 32, kb = item / nblk, nb = item % nblk, k0 = 64 * kb, n0 = 32 * nb;
#pragma unroll
    for (int i = 0; i < 32; ++i) { const int kk = 2 * i + (lane >> 5); scr[kk * 33 + (lane & 31)] = W[(size_t)(k0 + kk) * N + n0 + (lane & 31)]; }
    LDS_WAIT(); asm volatile("" ::: "memory");
    int rb = n0; if (up_perm) { const int hi = n0 >= FF ? 1 : 0, cc = n0 - hi * FF; rb = (cc >> 7) * 256 + hi * 128 + (cc & 127); }
    const int c = lane & 7;
#pragma unroll
    for (int j = 0; j < 4; ++j) { const int n = (lane >> 3) + 8 * j; const LAS float* s = scr + (8 * c) * 33 + n;
        v4u o; o.x = pk2(s[0 * 33], s[1 * 33]); o.y = pk2(s[2 * 33], s[3 * 33]); o.z = pk2(s[4 * 33], s[5 * 33]); o.w = pk2(s[6 * 33], s[7 * 33]);
        *(v4u*)(WT + (size_t)(rb + n) * K + k0 + 8 * c) = o; }
    LDS_WAIT(); asm volatile("" ::: "memory");
}

struct P {
    const float *xp, *xs, *st_h, *st_conv, *st_ffn, *g_pre1, *w_in, *w_conv_a, *b_conv_a, *w_r, *b_r, *w_i, *b_i, *lam, *g_out_a, *g_v, *b_v, *w_s, *b_s, *g_out_b, *w_o, *g_post1, *g_pre2, *w_up,
                *w_conv_f, *b_conv_f, *w_down, *g_post2;
    float* out; unsigned char* ws;
};
__device__ __forceinline__ const float* xrow(const P& p, int m) { return m < MP ? p.xp + (size_t)m * D : p.xs + (size_t)(m - MP) * D; }

template <int R> __device__ __forceinline__ void wave_sum_n(float (&v)[R]) {
#pragma unroll
    for (int r = 0; r < R; ++r) v[r] = wave_sum(v[r]);
}
__device__ __forceinline__ float sumsq4(const f32x4 v) { return (v.x * v.x + v.y * v.y) + (v.z * v.z + v.w * v.w); }
__device__ __forceinline__ unsigned long long pk4(const f32x4 v) { return (unsigned long long)pk2(v.x, v.y) | ((unsigned long long)pk2(v.z, v.w) << 32); }
template <int R> __device__ __forceinline__ void rows_pre1(const P& p, int m0, int lane) {
    const f32x4* gr = (const f32x4*)p.g_pre1 + lane;
    f32x4 v[R][4]; float s[R];
#pragma unroll
    for (int r = 0; r < R; ++r) { const f32x4* xr = (const f32x4*)xrow(p, m0 + r) + lane;
#pragma unroll
        for (int j = 0; j < 4; ++j) v[r][j] = xr[64 * j]; }
#pragma unroll
    for (int r = 0; r < R; ++r) { s[r] = 0.f;
#pragma unroll
        for (int j = 0; j < 4; ++j) s[r] += sumsq4(v[r][j]); }
    wave_sum_n<R>(s);
    f32x4 g[4];
#pragma unroll
    for (int j = 0; j < 4; ++j) g[j] = gr[64 * j];
#pragma unroll
    for (int r = 0; r < R; ++r) { const float rs = 1.0f / sqrtf(s[r] * (1.f / D) + EPS);
        unsigned long long* o8 = (unsigned long long*)((bf16*)(p.ws + WS_XN) + (size_t)(m0 + r) * D) + lane;
#pragma unroll
        for (int j = 0; j < 4; ++j) o8[64 * j] = pk4(v[r][j] * rs * g[j]); }
}
template <int R> __device__ __forceinline__ void rows_post1(const P& p, int m0, int lane) {
    const f32x4* g1 = (const f32x4*)p.g_post1 + lane; const f32x4* g2 = (const f32x4*)p.g_pre2 + lane;
    f32x4 y[R][4], x[R][4]; float s[R];
#pragma unroll
    for (int r = 0; r < R; ++r) { const int m = m0 + r; const f32x4* xr = (const f32x4*)xrow(p, m) + lane; const f32x4* yr = (const f32x4*)(p.out + O_Y + (size_t)m * D) + lane;
#pragma unroll
        for (int j = 0; j < 4; ++j) { x[r][j] = xr[64 * j];
            if (m < MP) y[r][j] = yr[64 * j];
            else { const f32x4* yp = (const f32x4*)((const float*)(p.ws + WS_YP) + (size_t)(m - MP) * D) + lane + 64 * j; y[r][j] = (yp[0] + yp[262144]) + (yp[2 * 262144] + yp[3 * 262144]); } } }
#pragma unroll
    for (int r = 0; r < R; ++r) { s[r] = 0.f;
#pragma unroll
        for (int j = 0; j < 4; ++j) s[r] += sumsq4(y[r][j]); }
    wave_sum_n<R>(s);
    f32x4 gg[4];
#pragma unroll
    for (int j = 0; j < 4; ++j) gg[j] = g1[64 * j];
    float s2[R];
#pragma unroll
    for (int r = 0; r < R; ++r) { const float rs = 1.0f / sqrtf(s[r] * (1.f / D) + EPS); f32x4* yr = (f32x4*)(p.out + O_Y + (size_t)(m0 + r) * D) + lane; s2[r] = 0.f;
#pragma unroll
        for (int j = 0; j < 4; ++j) { y[r][j] = x[r][j] + y[r][j] * rs * gg[j]; yr[64 * j] = y[r][j]; s2[r] += sumsq4(y[r][j]); } }
    wave_sum_n<R>(s2);
#pragma unroll
    for (int j = 0; j < 4; ++j) gg[j] = g2[64 * j];
#pragma unroll
    for (int r = 0; r < R; ++r) { const int m = m0 + r; const float rs2 = 1.0f / sqrtf(s2[r] * (1.f / D) + EPS);
        unsigned long long* o8 = (unsigned long long*)((bf16*)(p.ws + WS_XN) + (size_t)m * D) + lane;
        unsigned long long* b8 = nullptr;
        if (m < MP - 64 && (m & 63) >= 62) b8 = (unsigned long long*)((bf16*)(p.ws + WS_XNB) + (size_t)(2 * ((m >> 6) + 1) + (m & 63) - 62) * D) + lane;
#pragma unroll
        for (int j = 0; j < 4; ++j) { const unsigned long long w = pk4(y[r][j] * rs2 * gg[j]); o8[64 * j] = w; if (b8) b8[64 * j] = w; } }
}
template <int R> __device__ __forceinline__ void rows_post2(const P& p, int m0, int lane) {
    const f32x4* g1 = (const f32x4*)p.g_post2 + lane;
    f32x4 y[R][4], x[R][4]; float s[R];
#pragma unroll
    for (int r = 0; r < R; ++r) { const int m = m0 + r; const f32x4* fr = (const f32x4*)((const float*)(p.ws + WS_F) + (size_t)m * D) + lane; const f32x4* yr = (const f32x4*)(p.out + O_Y + (size_t)m * D) + lane;
#pragma unroll
        for (int j = 0; j < 4; ++j) { x[r][j] = yr[64 * j];
            if (m < MP) y[r][j] = fr[64 * j];
            else { const f32x4* fp = (const f32x4*)((const float*)(p.ws + WS_FP) + (size_t)(m - MP) * D) + lane + 64 * j;
                y[r][j] = ((fp[0] + fp[262144]) + (fp[2 * 262144] + fp[3 * 262144])) + ((fp[4 * 262144] + fp[5 * 262144]) + (fp[6 * 262144] + fp[7 * 262144])); } } }
#pragma unroll
    for (int r = 0; r < R; ++r) { s[r] = 0.f;
#pragma unroll
        for (int j = 0; j < 4; ++j) s[r] += sumsq4(y[r][j]); }
    wave_sum_n<R>(s);
    f32x4 gg[4];
#pragma unroll
    for (int j = 0; j < 4; ++j) gg[j] = g1[64 * j];
#pragma unroll
    for (int r = 0; r < R; ++r) { const float rs = 1.0f / sqrtf(s[r] * (1.f / D) + EPS); f32x4* yr = (f32x4*)(p.out + O_Y + (size_t)(m0 + r) * D) + lane;
#pragma unroll
        for (int j = 0; j < 4; ++j) yr[64 * j] = x[r][j] + y[r][j] * rs * gg[j]; }
}

constexpr int MA_WL = 10752, MA_YS = 8 * MA_WL;
template <bool FINAL>
__device__ __forceinline__ void mixer_a_item(const P& p, LAS unsigned char* lds, int q, int wave, int lane) {
    asm volatile("" : "+v"(lane));
    const bool smp = q >= 256; const int b = q >> 5, cc = q & 31, sidx = q - 256;
    const int row0 = smp ? MP + sidx * SSEQ : b * SEQ + cc * 64;
    const int c = wave * 64 + lane;
    const bf16* Z = (const bf16*)(p.ws + WS_Z);
    float* AGG = (float*)(p.ws + WS_AGG);
    LAS unsigned char* wl = lds + wave * MA_WL;
    LAS bf16* XC = (LAS bf16*)wl;
    LAS float* RB = (LAS float*)(wl + 2560);
    LAS float* IB = (LAS float*)(wl + 2560 + 4096);
    LAS float* YS = (LAS float*)(lds + MA_YS);
    const bf16x8* wfrag = (const bf16x8*)(p.ws + WS_WRF) + (size_t)wave * 8 * 64 + lane;
    const float cw0 = p.w_conv_a[c], cw1 = p.w_conv_a[DA + c], cw2 = p.w_conv_a[2 * DA + c], cw3 = p.w_conv_a[3 * DA + c], cb = p.b_conv_a[c];
    const float br = p.b_r[c], bi = p.b_i[c];
    const float m8sp = -8.0f * log1pf(expf(-p.lam[c]));
    float xm3, xm2, xm1, h;
    if (smp) { const float* sc = p.st_conv + (size_t)sidx * 3 * DA; xm3 = sc[c]; xm2 = sc[DA + c]; xm1 = sc[2 * DA + c]; h = FINAL ? p.st_h[(size_t)sidx * DA + c] : 0.f; }
    else if (cc == 0) { xm3 = xm2 = xm1 = 0.f; h = 0.f; }
    else { const bf16* zp = Z + (size_t)(row0 - 3) * DIN + DA + c; xm3 = bf2f(zp[0]); xm2 = bf2f(zp[DIN]); xm1 = bf2f(zp[2 * DIN]); h = 0.f;
        if (FINAL) { const float* ag = AGG + (size_t)(b * 32) * 2 * DA + c;
#pragma unroll 1
            for (int k0 = 0; k0 < cc; k0 += 16) { float Pk[16], Hk[16];
#pragma unroll
                for (int j = 0; j < 16; ++j) { const int kk = (k0 + j < cc) ? k0 + j : 0; Pk[j] = ag[(size_t)kk * 2 * DA]; Hk[j] = ag[(size_t)kk * 2 * DA + DA]; }
#pragma unroll
                for (int j = 0; j < 16; ++j) if (k0 + j < cc) h = Pk[j] * h + Hk[j]; } } }
    const bool first = !smp && cc == 0;
    float slog = 0.f;
    bf16* MIX = (bf16*)(p.ws + WS_MIX);
    const f32x4 ga = *(const f32x4*)(p.g_out_a + lane * 8), gb = *(const f32x4*)(p.g_out_a + lane * 8 + 4);
    unsigned short xr[16], gr[16];
    { const bf16* zr0 = Z + (size_t)row0 * DIN + c;
#pragma unroll
      for (int tt = 0; tt < 16; ++tt) { xr[tt] = zr0[(size_t)tt * DIN + DA]; gr[tt] = FINAL ? zr0[(size_t)tt * DIN] : (unsigned short)0; } }
#pragma unroll 1
    for (int sc = 0; sc < 4; ++sc) {
        float xc[16];
#pragma unroll
        for (int tt = 0; tt < 16; ++tt) { const float xin = bf2f(xr[tt]);
            const float v = cb + cw0 * xm3 + cw1 * xm2 + cw2 * xm1 + cw3 * xin; xm3 = xm2; xm2 = xm1; xm1 = xin; xc[tt] = v; XC[tt * 72 + lane] = (bf16)f2bf(v); }
        float gt[16];
#pragma unroll
        for (int tt = 0; tt < 16; ++tt) gt[tt] = bf2f(gr[tt]);
        if (sc < 3) { const bf16* zn = Z + (size_t)(row0 + (sc + 1) * 16) * DIN + c;
#pragma unroll
            for (int tt = 0; tt < 16; ++tt) { xr[tt] = zn[(size_t)tt * DIN + DA]; if (FINAL) gr[tt] = zn[(size_t)tt * DIN]; } }
        LDS_WAIT();
        const bf16x8 a0 = *(const LAS bf16x8*)(XC + (lane & 15) * 72 + (lane >> 4) * 8), a1 = *(const LAS bf16x8*)(XC + (lane & 15) * 72 + 32 + (lane >> 4) * 8);
#pragma unroll
        for (int nt = 0; nt < 4; ++nt) { pg8::f32x4 ar = {0.f, 0.f, 0.f, 0.f}, ai = {0.f, 0.f, 0.f, 0.f};
            const bf16x8 br0 = wfrag[nt * 64], br1 = wfrag[(4 + nt) * 64], bi0 = wfrag[(size_t)8 * 8 * 64 + nt * 64], bi1 = wfrag[(size_t)8 * 8 * 64 + (4 + nt) * 64];
            ar = __builtin_amdgcn_mfma_f32_16x16x32_bf16(a0, br0, ar, 0, 0, 0); ar = __builtin_amdgcn_mfma_f32_16x16x32_bf16(a1, br1, ar, 0, 0, 0);
            ai = __builtin_amdgcn_mfma_f32_16x16x32_bf16(a0, bi0, ai, 0, 0, 0); ai = __builtin_amdgcn_mfma_f32_16x16x32_bf16(a1, bi1, ai, 0, 0, 0);
#pragma unroll
            for (int r = 0; r < 4; ++r) { RB[((lane >> 4) * 4 + r) * 64 + nt * 16 + (lane & 15)] = ar[r]; IB[((lane >> 4) * 4 + r) * 64 + nt * 16 + (lane & 15)] = ai[r]; } }
        LDS_WAIT();
        if (FINAL && sc > 0) __syncthreads();
#pragma unroll
        for (int tt = 0; tt < 16; ++tt) {
            const float rg = sigmoidf_(RB[tt * 64 + lane] + br), ig = sigmoidf_(IB[tt * 64 + lane] + bi);
            const float la = m8sp * rg; const float a = __builtin_amdgcn_exp2f(1.4426950408889634f * la);
            const float x2 = la + la; const float ser = -x2 * (1.0f + x2 * (0.5f + x2 * (0.16666667f + x2 * (0.041666668f + x2 * 0.0083333338f))));
            const float om = x2 > -0.25f ? ser : 1.0f - a * a;
            float mult = __builtin_amdgcn_sqrtf(om); if (first && sc == 0 && tt == 0) mult = 1.0f;
            h = a * h + mult * (ig * xc[tt]); slog += la;
            if (FINAL) YS[tt * DA + c] = h * pg8::gelu_tanh(gt[tt]);
        }
        LDS_WAIT();
        if (FINAL) {
            __syncthreads();
#pragma unroll
            for (int tj = 0; tj < 2; ++tj) { const int t = wave * 2 + tj;
                const f32x4 va = *(const LAS f32x4*)(YS + t * DA + lane * 8), vb = *(const LAS f32x4*)(YS + t * DA + lane * 8 + 4);
                const float ss = wave_sum((va.x * va.x + va.y * va.y) + (va.z * va.z + va.w * va.w) + (vb.x * vb.x + vb.y * vb.y) + (vb.z * vb.z + vb.w * vb.w));
                const float rs = 1.0f / sqrtf(ss * (1.f / DA) + EPS);
                v4u o; o.x = pk2(va.x * rs * ga.x, va.y * rs * ga.y); o.y = pk2(va.z * rs * ga.z, va.w * rs * ga.w); o.z = pk2(vb.x * rs * gb.x, vb.y * rs * gb.y); o.w = pk2(vb.z * rs * gb.z, vb.w * rs * gb.w);
                *(v4u*)(MIX + (size_t)(row0 + sc * 16 + t) * D + lane * 8) = o; }
            LDS_WAIT();
        }
    }
    if (!FINAL) { AGG[(size_t)q * 2 * DA + c] = expf(slog); AGG[(size_t)q * 2 * DA + DA + c] = h; return; }
    if (smp || cc == 31) {
        float* oh = smp ? p.out + O_HS + (size_t)sidx * DA : p.out + O_HP + (size_t)b * DA; oh[c] = h;
        float* oc = smp ? p.out + O_CS + (size_t)sidx * 3 * DA : p.out + O_CP + (size_t)b * 3 * DA; oc[c] = xm3; oc[DA + c] = xm2; oc[2 * DA + c] = xm1;
    }
    __syncthreads();
}

template <int DUMMY>
__device__ __forceinline__ void mixer_a_pass1(const P& p, LAS unsigned char* lds, int q, int wave, int lane, float (&A)[64], float (&B)[64], float& xm3, float& xm2, float& xm1) {
    asm volatile("" : "+v"(lane));
    const int b = q >> 5, cc = q & 31; const int row0 = b * SEQ + cc * 64; const int c = wave * 64 + lane;
    const bf16* Z = (const bf16*)(p.ws + WS_Z); float* AGG = (float*)(p.ws + WS_AGG);
    LAS unsigned char* wl = lds + wave * MA_WL;
    LAS bf16* XC = (LAS bf16*)wl; LAS float* RB = (LAS float*)(wl + 2560); LAS float* IB = (LAS float*)(wl + 2560 + 4096);
    const bf16x8* wfrag = (const bf16x8*)(p.ws + WS_WRF) + (size_t)wave * 8 * 64 + lane;
    const float cw0 = p.w_conv_a[c], cw1 = p.w_conv_a[DA + c], cw2 = p.w_conv_a[2 * DA + c], cw3 = p.w_conv_a[3 * DA + c], cb = p.b_conv_a[c];
    const float br = p.b_r[c], bi = p.b_i[c];
    const float m8sp = -8.0f * log1pf(expf(-p.lam[c]));
    if (cc == 0) { xm3 = xm2 = xm1 = 0.f; }
    else { const bf16* zp = Z + (size_t)(row0 - 3) * DIN + DA + c; xm3 = bf2f(zp[0]); xm2 = bf2f(zp[DIN]); xm1 = bf2f(zp[2 * DIN]); }
    float h = 0.f, slog = 0.f;
    unsigned short xr[16];
    { const bf16* zr0 = Z + (size_t)row0 * DIN + DA + c;
#pragma unroll
      for (int tt = 0; tt < 16; ++tt) xr[tt] = zr0[(size_t)tt * DIN]; }
#pragma unroll
    for (int sc = 0; sc < 4; ++sc) {
        float xc[16];
#pragma unroll
        for (int tt = 0; tt < 16; ++tt) { const float xin = bf2f(xr[tt]);
            const float v = cb + cw0 * xm3 + cw1 * xm2 + cw2 * xm1 + cw3 * xin; xm3 = xm2; xm2 = xm1; xm1 = xin; xc[tt] = v; XC[tt * 72 + lane] = (bf16)f2bf(v); }
        if (sc < 3) { const bf16* zn = Z + (size_t)(row0 + (sc + 1) * 16) * DIN + DA + c;
#pragma unroll
            for (int tt = 0; tt < 16; ++tt) xr[tt] = zn[(size_t)tt * DIN]; }
        LDS_WAIT();
        const bf16x8 a0 = *(const LAS bf16x8*)(XC + (lane & 15) * 72 + (lane >> 4) * 8), a1 = *(const LAS bf16x8*)(XC + (lane & 15) * 72 + 32 + (lane >> 4) * 8);
#pragma unroll
        for (int nt = 0; nt < 4; ++nt) { pg8::f32x4 ar = {0.f, 0.f, 0.f, 0.f}, ai = {0.f, 0.f, 0.f, 0.f};
            const bf16x8 br0 = wfrag[nt * 64], br1 = wfrag[(4 + nt) * 64], bi0 = wfrag[(size_t)8 * 8 * 64 + nt * 64], bi1 = wfrag[(size_t)8 * 8 * 64 + (4 + nt) * 64];
            ar = __builtin_amdgcn_mfma_f32_16x16x32_bf16(a0, br0, ar, 0, 0, 0); ar = __builtin_amdgcn_mfma_f32_16x16x32_bf16(a1, br1, ar, 0, 0, 0);
            ai = __builtin_amdgcn_mfma_f32_16x16x32_bf16(a0, bi0, ai, 0, 0, 0); ai = __builtin_amdgcn_mfma_f32_16x16x32_bf16(a1, bi1, ai, 0, 0, 0);
#pragma unroll
            for (int r = 0; r < 4; ++r) { RB[((lane >> 4) * 4 + r) * 64 + nt * 16 + (lane & 15)] = ar[r]; IB[((lane >> 4) * 4 + r) * 64 + nt * 16 + (lane & 15)] = ai[r]; } }
        LDS_WAIT();
#pragma unroll
        for (int tt = 0; tt < 16; ++tt) {
            const float rg = sigmoidf_(RB[tt * 64 + lane] + br), ig = sigmoidf_(IB[tt * 64 + lane] + bi);
            const float la = m8sp * rg; const float a = __builtin_amdgcn_exp2f(1.4426950408889634f * la);
            const float x2 = la + la; const float ser = -x2 * (1.0f + x2 * (0.5f + x2 * (0.16666667f + x2 * (0.041666668f + x2 * 0.0083333338f))));
            const float om = x2 > -0.25f ? ser : 1.0f - a * a;
            float mult = __builtin_amdgcn_sqrtf(om); if (cc == 0 && sc == 0 && tt == 0) mult = 1.0f;
            const float bt = mult * (ig * xc[tt]);
            A[sc * 16 + tt] = a; B[sc * 16 + tt] = bt; h = a * h + bt; slog += la;
        }
        LDS_WAIT();
        __builtin_amdgcn_sched_barrier(0);
    }
    AGG[(size_t)q * 2 * DA + c] = expf(slog); AGG[(size_t)q * 2 * DA + DA + c] = h;
}
template <int DUMMY>
__device__ __forceinline__ void mixer_a_pass2(const P& p, LAS unsigned char* lds, int q, int wave, int lane, const float (&A)[64], const float (&B)[64], float xm3, float xm2, float xm1) {
    asm volatile("" : "+v"(lane));
    const int b = q >> 5, cc = q & 31; const int row0 = b * SEQ + cc * 64; const int c = wave * 64 + lane;
    const bf16* Z = (const bf16*)(p.ws + WS_Z); const float* AGG = (const float*)(p.ws + WS_AGG);
    LAS float* YS = (LAS float*)(lds + MA_YS);
    bf16* MIX = (bf16*)(p.ws + WS_MIX);
    unsigned short gr[16];
    { const bf16* zr0 = Z + (size_t)row0 * DIN + c;
#pragma unroll
      for (int tt = 0; tt < 16; ++tt) gr[tt] = zr0[(size_t)tt * DIN]; }
    float h = 0.f;
    { const float* ag = AGG + (size_t)(b * 32) * 2 * DA + c;
#pragma unroll 1
      for (int k0 = 0; k0 < cc; k0 += 16) { float Pk[16], Hk[16];
#pragma unroll
          for (int j = 0; j < 16; ++j) { const int kk = (k0 + j < cc) ? k0 + j : 0; Pk[j] = ag[(size_t)kk * 2 * DA]; Hk[j] = ag[(size_t)kk * 2 * DA + DA]; }
#pragma unroll
          for (int j = 0; j < 16; ++j) if (k0 + j < cc) h = Pk[j] * h + Hk[j]; } }
    const f32x4 ga = *(const f32x4*)(p.g_out_a + lane * 8), gb = *(const f32x4*)(p.g_out_a + lane * 8 + 4);
#pragma unroll
    for (int sc = 0; sc < 4; ++sc) {
        float gt[16];
#pragma unroll
        for (int tt = 0; tt < 16; ++tt) gt[tt] = bf2f(gr[tt]);
        if (sc < 3) { const bf16* zn = Z + (size_t)(row0 + (sc + 1) * 16) * DIN + c;
#pragma unroll
            for (int tt = 0; tt < 16; ++tt) gr[tt] = zn[(size_t)tt * DIN]; }
        if (sc > 0) __syncthreads();
#pragma unroll
        for (int tt = 0; tt < 16; ++tt) { h = A[sc * 16 + tt] * h + B[sc * 16 + tt]; YS[tt * DA + c] = h * pg8::gelu_tanh(gt[tt]); }
        LDS_WAIT();
        __syncthreads();
#pragma unroll
        for (int tj = 0; tj < 2; ++tj) { const int t = wave * 2 + tj;
            const f32x4 va = *(const LAS f32x4*)(YS + t * DA + lane * 8), vb = *(const LAS f32x4*)(YS + t * DA + lane * 8 + 4);
            const float ss = wave_sum((va.x * va.x + va.y * va.y) + (va.z * va.z + va.w * va.w) + (vb.x * vb.x + vb.y * vb.y) + (vb.z * vb.z + vb.w * vb.w));
            const float rs = 1.0f / sqrtf(ss * (1.f / DA) + EPS);
            v4u o; o.x = pk2(va.x * rs * ga.x, va.y * rs * ga.y); o.y = pk2(va.z * rs * ga.z, va.w * rs * ga.w); o.z = pk2(vb.x * rs * gb.x, vb.y * rs * gb.y); o.w = pk2(vb.z * rs * gb.z, vb.w * rs * gb.w);
            *(v4u*)(MIX + (size_t)(row0 + sc * 16 + t) * D + lane * 8) = o; }
        LDS_WAIT();
        __builtin_amdgcn_sched_barrier(0);
    }
    if (cc == 31) { p.out[O_HP + (size_t)b * DA + c] = h; float* oc = p.out + O_CP + (size_t)b * 3 * DA; oc[c] = xm3; oc[DA + c] = xm2; oc[2 * DA + c] = xm1; }
    __syncthreads();
}

#ifndef B1_REPS
#define B1_REPS 1
#endif
#ifndef B2_REPS
#define B2_REPS 1
#endif
constexpr int VNP = 528;
constexpr int MB_GOB = 128 * VNP * 2;
__device__ __forceinline__ void mixer_b_item(const P& p, LAS unsigned char* lds, int k, int wave, int lane) {
    asm volatile("" : "+v"(lane));
    const bool smp = k >= 128; const int sidx = k - 128; const int L = smp ? 64 : 128; const int row0 = smp ? MP + sidx * SSEQ : k * 128;
    const bf16* Z = (const bf16*)(p.ws + WS_Z);
    LAS bf16* VN = (LAS bf16*)lds;
    LAS float* GOB = (LAS float*)(lds + MB_GOB);
    GOB[threadIdx.x] = p.g_out_b[threadIdx.x];
    const int RW = L / 8;
    {
    const f32x4 gv0 = *(const f32x4*)(p.g_v + lane * 8), gv1 = *(const f32x4*)(p.g_v + lane * 8 + 4), bv0 = *(const f32x4*)(p.b_v + lane * 8), bv1 = *(const f32x4*)(p.b_v + lane * 8 + 4);
#pragma unroll 1
    for (int b1_ = 0; b1_ < B1_REPS; ++b1_)
#pragma unroll 1
    for (int jj = 0; jj < RW; jj += 4) { const int j0 = wave * RW + jj;
        f32x4 va[4], vb[4]; float s[4];
#pragma unroll
        for (int r = 0; r < 4; ++r) { const v4u raw = *(const v4u*)(Z + (size_t)(row0 + j0 + r) * DIN + 3 * DA + lane * 8);
            va[r] = (f32x4){__builtin_bit_cast(float, raw.x << 16), __builtin_bit_cast(float, raw.x & 0xffff0000u), __builtin_bit_cast(float, raw.y << 16), __builtin_bit_cast(float, raw.y & 0xffff0000u)};
            vb[r] = (f32x4){__builtin_bit_cast(float, raw.z << 16), __builtin_bit_cast(float, raw.z & 0xffff0000u), __builtin_bit_cast(float, raw.w << 16), __builtin_bit_cast(float, raw.w & 0xffff0000u)};
            s[r] = ((va[r].x + va[r].y) + (va[r].z + va[r].w)) + ((vb[r].x + vb[r].y) + (vb[r].z + vb[r].w)); }
        wave_sum_n<4>(s);
        float s2[4];
#pragma unroll
        for (int r = 0; r < 4; ++r) { const float mu = s[r] * (1.f / DB); va[r] = va[r] - mu; vb[r] = vb[r] - mu; s2[r] = sumsq4(va[r]) + sumsq4(vb[r]); }
        wave_sum_n<4>(s2);
#pragma unroll
        for (int r = 0; r < 4; ++r) { const float rstd = 1.0f / sqrtf(s2[r] * (1.f / DB) + EPS); const int j = j0 + r;
            const f32x4 na = va[r] * rstd * gv0 + bv0, nb = vb[r] * rstd * gv1 + bv1;
            v4u o; o.x = pk2(na.x, na.y); o.y = pk2(na.z, na.w); o.z = pk2(nb.x, nb.y); o.w = pk2(nb.z, nb.w);
            *(LAS v4u*)(VN + j * VNP + lane * 8) = o;
            if (smp) { float* ov = p.out + O_VS + ((size_t)sidx * SSEQ + j) * DB + lane * 8; *(f32x4*)ov = na; *(f32x4*)(ov + 4) = nb; } }
    }
    }
    __syncthreads();
    if (wave * 16 < L) {
        const int i0 = wave * 16, nks = (smp || i0 < 64) ? 2 : 4;
        int il = lane & 15, kg = lane >> 4; asm volatile("" : "+v"(il), "+v"(kg));
        const int row = row0 + i0 + il;
        bf16* MIX = (bf16*)(p.ws + WS_MIX);
        bf16x8 wf[2][4]; v2u uraw[4][8]; float bsv[4];
        const bf16x8* wsf = (const bf16x8*)(p.ws + WS_WSF) + (size_t)wave * 4 * 64 + lane;
#pragma unroll
        for (int hh = 0; hh < 4; ++hh) { bsv[hh] = p.b_s[hh * 128 + i0 + il];
#pragma unroll
            for (int dt = 0; dt < 8; ++dt) uraw[hh][dt] = *(const v2u*)(Z + (size_t)row * DIN + 2 * DA + hh * 128 + dt * 16 + kg * 4);
        }
#pragma unroll
        for (int ks = 0; ks < 4; ++ks) wf[0][ks] = wsf[ks * 64];
        float ss = 0.f, rs = 0.f;
#pragma unroll 1
        for (int pass = 0; pass < 2 * B2_REPS; ++pass) {
            bf16* mrow = MIX + (size_t)row * D + DA + kg * 4; unsigned gobo = (unsigned)(MB_GOB + kg * 16);
            asm volatile("" : "+v"(mrow), "+v"(gobo));
#pragma unroll
            for (int hh = 0; hh < 4; ++hh) {
#pragma unroll
                for (int ks = 0; ks < 4; ++ks) wf[(hh + 1) & 1][ks] = wsf[(size_t)(((hh + 1) & 3) * 8 * 4 + ks) * 64];
                unsigned vbase = (unsigned)(((kg * 8 + (il >> 2)) * VNP + hh * 128 + 4 * (il & 3)) * 2);
                asm volatile("" : "+v"(vbase));
#pragma unroll
                for (int dt = 0; dt < 8; ++dt) { pg8::f32x4 a = {0.f, 0.f, 0.f, 0.f};
#pragma unroll
                    for (int ks = 0; ks < 4; ++ks) if (ks < nks) { const LAS bf16* vp = (const LAS bf16*)(lds + vbase) + (ks * 32) * VNP + dt * 16;
                        typedef short s16x4 __attribute__((ext_vector_type(4)));
                        const s16x4 lo = __builtin_amdgcn_ds_read_tr16_b64_v4i16((LAS s16x4*)vp), hi = __builtin_amdgcn_ds_read_tr16_b64_v4i16((LAS s16x4*)(vp + 4 * VNP));
                        const bf16x8 af = {lo[0], lo[1], lo[2], lo[3], hi[0], hi[1], hi[2], hi[3]};
                        a = __builtin_amdgcn_mfma_f32_16x16x32_bf16(af, wf[hh & 1][ks], a, 0, 0, 0); }
                    const v2u ur = uraw[hh][dt];
                    const pg8::f32x4 u4 = {__builtin_bit_cast(float, ur.x << 16), __builtin_bit_cast(float, ur.x & 0xffff0000u), __builtin_bit_cast(float, ur.y << 16), __builtin_bit_cast(float, ur.y & 0xffff0000u)};
                    const pg8::f32x4 yv = u4 * (a + bsv[hh]);
                    if ((pass & 1) == 0) ss += (yv[0] * yv[0] + yv[1] * yv[1]) + (yv[2] * yv[2] + yv[3] * yv[3]);
                    else { const f32x4 g = *(const LAS f32x4*)(lds + gobo + (hh * 128 + dt * 16) * 4);
                        v2u o; o.x = pk2(yv[0] * rs * g.x, yv[1] * rs * g.y); o.y = pk2(yv[2] * rs * g.z, yv[3] * rs * g.w);
                        *(v2u*)(mrow + hh * 128 + dt * 16) = o; }
                    __builtin_amdgcn_sched_barrier(0);
                }
            }
            if ((pass & 1) == 0) { ss += __shfl_xor(ss, 16); ss += __shfl_xor(ss, 32); rs = 1.0f / sqrtf(ss * (1.f / DB) + EPS); ss = 0.f; }
        }
    }
    __syncthreads();
}

#define XB_TMO      128
#define XB_XCNT(j)  (256  + 64 * (j))
#define XB_XSUB(j)  (1280 + 64 * (j))
#define XB_XGEN(j)  (2304 + 64 * (j))
#define XB_TOP      3328
#define XB_TOPGEN   3392
#define XCD_BAR_WORDS 3456
#define XB_SPIN_CAP (1u << 18)

__device__ __forceinline__ unsigned xb_ld(unsigned* p)              { return __hip_atomic_load(p, __ATOMIC_RELAXED, __HIP_MEMORY_SCOPE_AGENT); }
__device__ __forceinline__ unsigned xb_add(unsigned* p, unsigned v) { return __hip_atomic_fetch_add(p, v, __ATOMIC_RELAXED, __HIP_MEMORY_SCOPE_AGENT); }
__device__ __forceinline__ unsigned xb_xcc_id() { return (unsigned)__builtin_amdgcn_s_getreg((3 << 11) | 20) & 0xFu; }
#define XB_SPIN(cond, bar) do { unsigned _sp = 0; while (cond) { __builtin_amdgcn_s_sleep(1); \
    if ((++_sp & 255u) == 0u) { if (xb_ld(&(bar)[XB_TMO])) break; if (_sp > XB_SPIN_CAP) { atomicAdd(&(bar)[XB_TMO], 1u); break; } } } } while (0)

struct XcdBarrier {
    unsigned* bar; unsigned x;
    volatile LAS unsigned* st;
};

__device__ __forceinline__ XcdBarrier xcd_barrier_post(unsigned* bar, volatile LAS unsigned* st) {
    XcdBarrier b; b.bar = bar; b.x = xb_xcc_id(); b.st = st;
    if (threadIdx.x == 0) (void)xb_add(&bar[XB_XCNT(b.x)], 1u);
    return b;
}
__device__ __forceinline__ void xcd_barrier_complete(unsigned* bar, unsigned x, unsigned& nloc, unsigned& nx) {
    const unsigned G = gridDim.x * gridDim.y * gridDim.z;
    unsigned sum, cnt, mine, sp = 0u;
    for (;;) {
        sum = 0u; cnt = 0u; mine = 0u;
#pragma unroll
        for (unsigned j = 0; j < 16; ++j) { const unsigned c = xb_ld(&bar[XB_XCNT(j)]); sum += c; cnt += (c > 0u) ? 1u : 0u; mine = (j == x) ? c : mine; }
        if (sum == G) break;
        __builtin_amdgcn_s_sleep(1);
        if ((++sp & 255u) == 0u) { if (xb_ld(&bar[XB_TMO])) break; if (sp > XB_SPIN_CAP) { atomicAdd(&bar[XB_TMO], 1u); break; } }
    }
    nloc = mine > 0u ? mine : 1u; nx = cnt > 0u ? cnt : 1u;
}

__device__ __forceinline__ void xcd_barrier(const XcdBarrier& b) {
    asm volatile("s_waitcnt vmcnt(0)" ::: "memory");
    __syncthreads();
    if (threadIdx.x == 0) {
        unsigned* bar = b.bar;
        __builtin_amdgcn_s_waitcnt(0);
        unsigned nloc = b.st[0], nx = b.st[1];
        if (nloc == 0u) { xcd_barrier_complete(bar, b.x, nloc, nx); b.st[0] = nloc; b.st[1] = nx; }
        const unsigned old = xb_add(&bar[XB_XSUB(b.x)], 1u);
        const unsigned gen = old / nloc;
        if (old + 1u == (gen + 1u) * nloc) {
            __builtin_amdgcn_fence(__ATOMIC_RELEASE, "agent");
            asm volatile("s_waitcnt vmcnt(0)" ::: "memory");
            const unsigned og = xb_add(&bar[XB_TOP], 1u);
            const unsigned tg = og / nx;
            if (og + 1u == (tg + 1u) * nx) xb_add(&bar[XB_TOPGEN], 1u);
            else XB_SPIN(xb_ld(&bar[XB_TOPGEN]) == tg, bar);
            __builtin_amdgcn_fence(__ATOMIC_ACQUIRE, "agent");
            xb_add(&bar[XB_XGEN(b.x)], 1u);
            asm volatile("s_waitcnt vmcnt(0)" ::: "memory");
        } else {
            XB_SPIN(xb_ld(&bar[XB_XGEN(b.x)]) == gen, bar);
            __builtin_amdgcn_fence(__ATOMIC_ACQUIRE, "agent");
            asm volatile("s_waitcnt vmcnt(0)" ::: "memory");
        }
    }
    __syncthreads();
}

struct Args { const float* in[28]; float* out; unsigned char* ws; int ph_lo, ph_hi; };
constexpr int NPH = 10;
__global__ void __launch_bounds__(512, 2) fwd(Args args) {
    extern __shared__ __attribute__((aligned(16))) unsigned char lds_raw[];
    LAS unsigned char* lds = (LAS unsigned char*)lds_raw;
    const int tid = threadIdx.x, lane = tid & 63, wave = __builtin_amdgcn_readfirstlane(tid >> 6);
    const int G = gridDim.x, bx = blockIdx.x;
    const int gw = bx * 8 + wave, NGW = G * 8;
    P p;
    p.xp = args.in[0]; p.xs = args.in[1]; p.st_h = args.in[2]; p.st_conv = args.in[3]; p.st_ffn = args.in[4]; p.g_pre1 = args.in[5]; p.w_in = args.in[6]; p.w_conv_a = args.in[7]; p.b_conv_a = args.in[8];
    p.w_r = args.in[9]; p.b_r = args.in[10]; p.w_i = args.in[11]; p.b_i = args.in[12]; p.lam = args.in[13]; p.g_out_a = args.in[14]; p.g_v = args.in[15]; p.b_v = args.in[16]; p.w_s = args.in[17]; p.b_s = args.in[18];
    p.g_out_b = args.in[19]; p.w_o = args.in[20]; p.g_post1 = args.in[21]; p.g_pre2 = args.in[22]; p.w_up = args.in[23]; p.w_conv_f = args.in[24]; p.b_conv_f = args.in[25]; p.w_down = args.in[26]; p.g_post2 = args.in[27];
    p.out = args.out; p.ws = args.ws;
    unsigned char* ws = args.ws;
    bf16 *Wt_in = (bf16*)(ws + WS_WIN), *Wt_o = (bf16*)(ws + WS_WO), *Wt_up = (bf16*)(ws + WS_WUP), *Wt_dn = (bf16*)(ws + WS_WDN);
    bf16 *XN = (bf16*)(ws + WS_XN), *Zb = (bf16*)(ws + WS_Z), *MIX = (bf16*)(ws + WS_MIX), *HB = (bf16*)(ws + WS_HB), *XNB = (bf16*)(ws + WS_XNB), *UB = (bf16*)(ws + WS_UB);
    float* Fb = (float*)(ws + WS_F);
    const int lo = args.ph_lo, hi = args.ph_hi;
    volatile LAS unsigned* MISC = (volatile LAS unsigned*)(lds + LDS_BYTES - 64);
    if (tid < 16) MISC[tid] = 0u;
    __syncthreads();
    XcdBarrier bar = xcd_barrier_post((unsigned*)(ws + WS_CTL) + 1024, MISC);
#ifndef PHASE_MASK
#define PHASE_MASK 0x3ff
#endif
#define IN(k) ((((PHASE_MASK) >> (k)) & 1) && lo <= (k) && (k) < hi)
#ifndef SYNC_REPS
#define SYNC_REPS 1
#endif
#ifndef MIX_REPS
#define MIX_REPS 1
#endif
#ifndef REP_MASK
#define REP_MASK 0
#endif
#define PHASE(k) for (int r_ = 0; r_ < ((((REP_MASK) >> (k)) & 1) ? 2 : 1); ++r_) if (r_ && (xcd_barrier(bar), false)) {} else if (IN(k))
#define SEAM(k) do { if (IN(k) && IN((k) + 1)) { for (int r_ = 0; r_ < SYNC_REPS; ++r_) xcd_barrier(bar); } } while (0)

    PHASE(0) {
        LAS float* scr = (LAS float*)(lds + wave * 16384);
        constexpr int I_IN = (D / 64) * (DIN / 32), I_O = (D / 64) * (D / 32), I_UP = (D / 64) * (FF2 / 32), I_DN = (FF / 64) * (D / 32);
        for (int it = gw; it < I_IN + I_O + I_UP + I_DN; it += NGW) { int r = it;
            if (r < I_IN) { p0_transpose_item(p.w_in, D, DIN, Wt_in, false, scr, r, lane); continue; } r -= I_IN;
            if (r < I_O) { p0_transpose_item(p.w_o, D, D, Wt_o, false, scr, r, lane); continue; } r -= I_O;
            if (r < I_UP) { p0_transpose_item(p.w_up, D, FF2, Wt_up, true, scr, r, lane); continue; } r -= I_UP;
            p0_transpose_item(p.w_down, FF, D, Wt_dn, false, scr, r, lane); }
        for (int idx = bx * 512 + tid; idx < 2 * 8 * 8 * 64 * 8; idx += G * 512) { const int j = idx & 7, ln = (idx >> 3) & 63, f = (idx >> 9) & 7, hh = (idx >> 12) & 7, mat = idx >> 15;
            const int d = (f >> 2) * 32 + (ln >> 4) * 8 + j, e = (f & 3) * 16 + (ln & 15);
            ((bf16*)(ws + WS_WRF))[idx] = (bf16)f2bf((mat ? p.w_i : p.w_r)[(size_t)hh * 4096 + d * 64 + e]); }
        for (int idx = bx * 512 + tid; idx < 4 * 8 * 4 * 64 * 8; idx += G * 512) { const int j = idx & 7, ln = (idx >> 3) & 63, ks = (idx >> 9) & 3, it = (idx >> 11) & 7, hh = idx >> 14;
            ((bf16*)(ws + WS_WSF))[idx] = (bf16)f2bf(p.w_s[((size_t)hh * 128 + it * 16 + (ln & 15)) * 128 + ks * 32 + (ln >> 4) * 8 + j]); }
        for (int m0 = gw * 2; m0 < M; m0 += NGW * 2) rows_pre1<2>(p, m0, lane);
        __syncthreads();
    }
    SEAM(0);
    PHASE(1) { pg8::Gemm g{XN, Wt_in, M, DIN, D, D}; pg8::ComboOrder S; S.init(MP, DIN, D, G, bx, 64, 4, 4);
        pg8::EpiZ E{Zb, DIN, (float*)(ws + WS_ZP), (size_t)1024 * DIN};
        pg8::gemm_phase<pg8::EpiZ, pg8::ComboOrder, true, true>(lds, g, S, E); }
    SEAM(1);
    float maA[64], maB[64], ma3 = 0.f, ma2 = 0.f, ma1 = 0.f;
    for (int rep_ = 0; rep_ < MIX_REPS; ++rep_) {
    PHASE(2) {
        for (int idx = bx * 512 + tid; idx < 1024 * (DIN / 8); idx += G * 512) {
            const f32x4* zp = (const f32x4*)(ws + WS_ZP) + (size_t)idx * 2; constexpr size_t SS = (size_t)1024 * DIN / 4;
            const f32x4 a = (zp[0] + zp[SS]) + (zp[2 * SS] + zp[3 * SS]), b2 = (zp[1] + zp[SS + 1]) + (zp[2 * SS + 1] + zp[3 * SS + 1]);
            v4u o; o.x = pk2(a.x, a.y); o.y = pk2(a.z, a.w); o.z = pk2(b2.x, b2.y); o.w = pk2(b2.z, b2.w);
            *((v4u*)(Zb + (size_t)MP * DIN) + idx) = o; }
        if (G == 256) mixer_a_pass1<0>(p, lds, bx, wave, lane, maA, maB, ma3, ma2, ma1); }
    SEAM(2);
#ifndef PASS2_REPS
#define PASS2_REPS 1
#endif
#ifndef R1_REPS
#define R1_REPS 1
#endif
    PHASE(3) { for (int r2_ = 0; r2_ < PASS2_REPS; ++r2_) if (G == 256) mixer_a_pass2<0>(p, lds, bx, wave, lane, maA, maB, ma3, ma2, ma1);
#ifndef R1A_REPS
#define R1A_REPS 0
#endif
        for (int r1_ = 0; r1_ < R1A_REPS; ++r1_) if (bx < 16) mixer_a_item<true>(p, lds, 256 + bx, wave, lane);
        for (int r1_ = 0; r1_ < R1_REPS; ++r1_)
        for (int it = bx; it < 16 + 144; it += G) { if (it < 16) mixer_a_item<true>(p, lds, 256 + it, wave, lane); else mixer_b_item(p, lds, it - 16, wave, lane); } }
    SEAM(3);
    }
    PHASE(4) { pg8::Gemm g{MIX, Wt_o, M, D, D, D}; pg8::ComboOrder S; S.init(MP, D, D, G, bx, 64, 4, 4);
        pg8::EpiF32 E{p.out + O_Y, D, nullptr, 64, (float*)(ws + WS_YP), (size_t)1024 * D};
        pg8::gemm_phase<pg8::EpiF32, pg8::ComboOrder, true, true>(lds, g, S, E); }
    SEAM(4);
    PHASE(5) { for (int m0 = gw * 2; m0 < M; m0 += NGW * 2) rows_post1<2>(p, m0, lane); }
    SEAM(5);
    PHASE(6) { pg8::Gemm g{XNB, Wt_up, 512, FF2, D, D}; pg8::StaticOrder S; S.init(512, FF2, D, G, bx);
        pg8::EpiBf16<0> E{UB, FF2, nullptr, 0, 0, 1.f};
        pg8::gemm_phase<pg8::EpiBf16<0>, pg8::StaticOrder, true, true>(lds, g, S, E); }
    SEAM(6);
    PHASE(7) { pg8::Gemm g{XN, Wt_up, M, FF2, D, D}; pg8::StaticOrder S; S.init(M, FF2, D, G, bx);
        pg8::EpiConvGeglu E{HB, UB, p.st_ffn, p.w_conv_f, p.b_conv_f, p.out + O_FP, p.out + O_FS};
        pg8::gemm_phase<pg8::EpiConvGeglu, pg8::StaticOrder, true, true>(lds, g, S, E); }
    SEAM(7);
    PHASE(8) { pg8::Gemm g{HB, Wt_dn, M, D, FF, FF}; pg8::ComboOrder S; S.init(MP, D, FF, G, bx, 64, 4, 8);
        pg8::EpiF32 E{Fb, D, nullptr, 64, (float*)(ws + WS_FP), (size_t)1024 * D};
        pg8::gemm_phase<pg8::EpiF32, pg8::ComboOrder, true, true>(lds, g, S, E); }
    SEAM(8);
    PHASE(9) { for (int m0 = gw * 2; m0 < M; m0 += NGW * 2) rows_post2<2>(p, m0, lane); }
#undef IN
#undef SEAM
}

extern "C" void kernel_launch(void* const* d_in, const int* in_sizes, int n_in, void* d_out, int out_size, void* d_ws, size_t ws_size, hipStream_t stream) {
    static int grid = 0;
    if (grid == 0) {
        if (n_in != 28 || (size_t)out_size != O_END || ws_size < WS_END) { fprintf(stderr, "kernel_launch: unexpected shapes: n_in %d out %d ws %zu\n", n_in, out_size, ws_size); grid = -1; return; }
        int dev = 0, cus = 0, per_cu = 0;
        if (hipGetDevice(&dev) != hipSuccess || hipDeviceGetAttribute(&cus, hipDeviceAttributeMultiprocessorCount, dev) != hipSuccess) { grid = -1; return; }
        if (hipFuncSetAttribute((const void*)fwd, hipFuncAttributeMaxDynamicSharedMemorySize, LDS_BYTES) != hipSuccess) { fprintf(stderr, "kernel_launch: hipFuncSetAttribute failed\n"); grid = -1; return; }
        if (hipOccupancyMaxActiveBlocksPerMultiprocessor(&per_cu, (const void*)fwd, 512, LDS_BYTES) != hipSuccess || per_cu < 1) { fprintf(stderr, "kernel_launch: occupancy query failed (%d)\n", per_cu); (void)hipGetLastError(); per_cu = 1; }
        grid = cus * 1;
        if (grid > 256) grid = 256;
    }
    if (grid < 0) return;
    if (hipMemsetAsync((char*)d_ws + WS_CTL, 0, CTL_ZERO_BYTES, stream) != hipSuccess) { fprintf(stderr, "kernel_launch: memset failed\n"); return; }
    Args a{};
    for (int i = 0; i < 28; ++i) a.in[i] = (const float*)d_in[i];
    a.out = (float*)d_out; a.ws = (unsigned char*)d_ws; a.ph_lo = 0; a.ph_hi = NPH;
    void* kargs[] = {&a};
    const hipError_t e = hipLaunchCooperativeKernel((const void*)fwd, dim3(grid), dim3(512), kargs, LDS_BYTES, stream);
    if (e != hipSuccess) fprintf(stderr, "kernel_launch: cooperative launch failed: %s (grid %d)\n", hipGetErrorString(e), grid);
}
```
